# Optimizing an MI355X kernel written in HIP

```python
import jax, jax.numpy as jnp
from jax import lax
import numpy as np

D_MODEL = 1024
BATCH = 16
SEQ = 2048
DEPTH = 1

PLE_DIM = 256
D_MIX = D_MODEL
MLSTM_HEADS = 4
MLSTM_HEAD_DIM = 128
MLSTM_WIDTH = MLSTM_HEADS * MLSTM_HEAD_DIM
HGRN_HEADS = 4
HGRN_HEAD_DIM = 128
HGRN_WIDTH = HGRN_HEADS * HGRN_HEAD_DIM
CONV_WIDTH = 4
MLSTM_CHUNK = 128
HGRN_CHUNK = 32
MLSTM_COLS = 4 * MLSTM_WIDTH + 2 * MLSTM_HEADS
HGRN_COLS = 4 * HGRN_WIDTH
IN_COLS = MLSTM_COLS + HGRN_COLS
N_GROUPS = 4
EXPERTS_PER_GROUP = 8
N_EXPERTS = N_GROUPS * EXPERTS_PER_GROUP
TOP_K = 2
D_EXPERT = 512
MOE_BLOCK = 128
EPS = 1e-6

kernel_name = "hybrid_mlstm_hgrn2_hmoe_block"


def rms_norm(u, g):
    u32 = u.astype(jnp.float32)
    y = u32 * lax.rsqrt(jnp.mean(u32 * u32, axis=-1, keepdims=True) + EPS) * g.astype(jnp.float32)
    return y.astype(u.dtype)


def to_chunks(u, n_heads, chunk):
    b, t, _ = u.shape
    return u.reshape(b, t // chunk, chunk, n_heads, -1).transpose(1, 0, 3, 2, 4)


def gates_to_chunks(u, chunk):
    b, t, h = u.shape
    return u.reshape(b, t // chunk, chunk, h).transpose(1, 0, 3, 2)


def from_chunks(u):
    nc, b, h, l, d = u.shape
    return u.transpose(1, 0, 3, 2, 4).reshape(b, nc * l, h, d)


def causal_depthwise_conv(u, w):
    k, c = w.shape
    return lax.conv_general_dilated(u, w[:, None, :].astype(u.dtype), window_strides=(1,),
                                    padding=[(k - 1, 0)], dimension_numbers=("NWC", "WIO", "NWC"),
                                    feature_group_count=c)


def mlstm_mixer(qk_pre, v_in, o_pre, gate_pre, conv_w, g_norm):
    b, t, _ = v_in.shape
    qk = jax.nn.silu(causal_depthwise_conv(qk_pre, conv_w)).astype(jnp.float32)
    q = qk[..., :MLSTM_WIDTH]
    k = qk[..., MLSTM_WIDTH:] * (MLSTM_HEAD_DIM ** -0.5)
    v = v_in.astype(jnp.float32)
    ig = gate_pre[..., :MLSTM_HEADS]
    lf = jax.nn.log_sigmoid(gate_pre[..., MLSTM_HEADS:])
    qc, kc, vc = (to_chunks(u, MLSTM_HEADS, MLSTM_CHUNK) for u in (q, k, v))
    igc, lfc = gates_to_chunks(ig, MLSTM_CHUNK), gates_to_chunks(lf, MLSTM_CHUNK)
    mask = jnp.tril(jnp.ones((MLSTM_CHUNK, MLSTM_CHUNK), bool))

    def step(carry, xs):
        c_st, n_st, m_st = carry
        qq, kk, vv, ii, ff = xs
        bcum = jnp.cumsum(ff, axis=-1)
        log_d = jnp.where(mask, bcum[..., :, None] - bcum[..., None, :] + ii[..., None, :], -jnp.inf)
        inter = bcum + m_st[..., None]
        m_t = jnp.maximum(inter, jnp.max(log_d, axis=-1))
        s = jnp.einsum("bhtd,bhsd->bhts", qq, kk) * jnp.exp(log_d - m_t[..., None])
        w_inter = jnp.exp(inter - m_t)
        num = jnp.einsum("bhts,bhse->bhte", s, vv) + w_inter[..., None] * jnp.einsum("bhtd,bhde->bhte", qq, c_st)
        den = jnp.sum(s, axis=-1) + w_inter * jnp.einsum("bhtd,bhd->bht", qq, n_st)
        h = num / jnp.maximum(jnp.abs(den), jnp.exp(-m_t))[..., None]
        b_last = bcum[..., -1]
        w_log = b_last[..., None] - bcum + ii
        m_new = jnp.maximum(b_last + m_st, jnp.max(w_log, axis=-1))
        w = jnp.exp(w_log - m_new[..., None])
        decay = jnp.exp(b_last + m_st - m_new)
        c_new = decay[..., None, None] * c_st + jnp.einsum("bhs,bhsd,bhse->bhde", w, kk, vv)
        n_new = decay[..., None] * n_st + jnp.einsum("bhs,bhsd->bhd", w, kk)
        return (c_new, n_new, m_new), h

    init = (jnp.zeros((b, MLSTM_HEADS, MLSTM_HEAD_DIM, MLSTM_HEAD_DIM), jnp.float32),
            jnp.zeros((b, MLSTM_HEADS, MLSTM_HEAD_DIM), jnp.float32),
            jnp.zeros((b, MLSTM_HEADS), jnp.float32))
    _, hc = lax.scan(step, init, (qc, kc, vc, igc, lfc))
    h = from_chunks(hc)
    h = h * jax.nn.sigmoid(o_pre.astype(jnp.float32)).reshape(h.shape)
    h = h * lax.rsqrt(jnp.mean(h * h, axis=-1, keepdims=True) + EPS)
    return (h.reshape(b, t, MLSTM_WIDTH) * g_norm.astype(jnp.float32)).astype(v_in.dtype)


def hgrn2_mixer(q_pre, f_pre, i_in, g_pre, lb, g_norm):
    b, t, _ = q_pre.shape
    q = jax.nn.silu(q_pre.astype(jnp.float32))
    f32p = f_pre.astype(jnp.float32)
    f = lb + (1.0 - lb) * jax.nn.sigmoid(f32p)
    k = (1.0 - lb) * jax.nn.sigmoid(-f32p)
    lf = jnp.log(f)
    v = i_in.astype(jnp.float32)
    qc, kc, vc, lfc = (to_chunks(u, HGRN_HEADS, HGRN_CHUNK) for u in (q, k, v, lf))
    mask = jnp.tril(jnp.ones((HGRN_CHUNK, HGRN_CHUNK), bool))[:, :, None]

    def step(s_st, xs):
        qq, kk, vv, ll = xs
        bcum = jnp.cumsum(ll, axis=2)
        diff = bcum[:, :, :, None, :] - bcum[:, :, None, :, :]
        decay = jnp.exp(jnp.where(mask, diff, -jnp.inf))
        a = jnp.einsum("bhtd,bhsd,bhtsd->bhts", qq, kk, decay)
        o = jnp.einsum("bhts,bhse->bhte", a, vv) + jnp.einsum("bhtd,bhde->bhte", qq * jnp.exp(bcum), s_st)
        b_last = bcum[:, :, -1:, :]
        s_new = jnp.exp(b_last[:, :, 0, :])[..., None] * s_st + \
            jnp.einsum("bhsd,bhse->bhde", kk * jnp.exp(b_last - bcum), vv)
        return s_new, o

    s0 = jnp.zeros((b, HGRN_HEADS, HGRN_HEAD_DIM, HGRN_HEAD_DIM), jnp.float32)
    _, oc = lax.scan(step, s0, (qc, kc, vc, lfc))
    o = from_chunks(oc)
    o = o * lax.rsqrt(jnp.mean(o * o, axis=-1, keepdims=True) + EPS) * g_norm.astype(jnp.float32)
    o = o.reshape(b, t, HGRN_WIDTH) * jax.nn.silu(g_pre.astype(jnp.float32))
    return o.astype(q_pre.dtype)


def hier_moe(h, w_rg, b_rg, w_re, b_re, w_gate, w_up, w_down):
    b, t, d = h.shape
    n_tok = b * t
    hf = h.reshape(n_tok, d)
    h32 = hf.astype(jnp.float32)
    g_logits = h32 @ w_rg.astype(jnp.float32) + b_rg.astype(jnp.float32)
    g_prob = jax.nn.softmax(g_logits, axis=-1)
    g_val, g_sel = lax.top_k(g_prob, 1)
    e_logits = (h32 @ w_re.astype(jnp.float32) + b_re.astype(jnp.float32)).reshape(n_tok, N_GROUPS, EXPERTS_PER_GROUP)
    e_in_group = jnp.take_along_axis(e_logits, g_sel[:, :, None], axis=1)[:, 0]
    top_v, top_i = lax.top_k(e_in_group, TOP_K)
    comb = jax.nn.softmax(top_v, axis=-1) * g_val
    expert_id = g_sel * EXPERTS_PER_GROUP + top_i

    n_asg = n_tok * TOP_K
    flat_e = expert_id.reshape(n_asg).astype(jnp.int32)
    flat_w = comb.reshape(n_asg)
    flat_tok = jnp.arange(n_asg, dtype=jnp.int32) // TOP_K
    order = jnp.argsort(flat_e)
    se, st, sw = flat_e[order], flat_tok[order], flat_w[order]
    counts = jnp.bincount(flat_e, length=N_EXPERTS).astype(jnp.int32)
    padded = (counts + MOE_BLOCK - 1) // MOE_BLOCK * MOE_BLOCK
    start = jnp.cumsum(counts) - counts
    pend = jnp.cumsum(padded)
    pstart = pend - padded
    dest = pstart[se] + jnp.arange(n_asg, dtype=jnp.int32) - start[se]
    n_blocks = -(-n_asg // MOE_BLOCK) + N_EXPERTS
    n_rows = n_blocks * MOE_BLOCK
    row_tok = jnp.full((n_rows,), n_tok, jnp.int32).at[dest].set(st)
    row_w = jnp.zeros((n_rows,), jnp.float32).at[dest].set(sw)
    block_e = jnp.minimum(jnp.searchsorted(pend, jnp.arange(n_blocks, dtype=jnp.int32) * MOE_BLOCK, side="right"),
                          N_EXPERTS - 1)
    x_pad = jnp.concatenate([hf, jnp.zeros((1, d), hf.dtype)], axis=0)
    xb = x_pad[row_tok].reshape(n_blocks, MOE_BLOCK, d)

    def expert_block(args):
        xblk, e = args
        return (jax.nn.silu(xblk @ w_gate[e]) * (xblk @ w_up[e])) @ w_down[e]

    yb = lax.map(expert_block, (xb, block_e)).reshape(n_rows, d)
    y = jax.ops.segment_sum(yb * row_w[:, None].astype(yb.dtype), row_tok, num_segments=n_tok + 1)[:n_tok]
    return y.reshape(b, t, d).astype(h.dtype)


def setup_inputs(seed: int = 0) -> dict:
    key = jax.random.key(seed)
    ks = jax.random.split(key, 24)
    f32 = jnp.float32

    def nrm(k, shape, scale):
        return jax.random.normal(k, shape, f32) * scale

    b_i = nrm(ks[4], (DEPTH, MLSTM_HEADS), 0.1)
    b_f = jnp.linspace(3.0, 6.0, MLSTM_HEADS, dtype=f32)[None, :] + nrm(ks[5], (DEPTH, MLSTM_HEADS), 0.1)
    return {
        "x": nrm(ks[0], (BATCH, SEQ, D_MODEL), 1.0),
        "p": nrm(ks[1], (DEPTH, BATCH, SEQ, PLE_DIM), 1.0),
        "g_mix": 1.0 + nrm(ks[2], (DEPTH, D_MODEL), 0.02),
        "w_in": nrm(ks[3], (DEPTH, D_MODEL, IN_COLS), D_MODEL ** -0.5),
        "b_mgate": jnp.concatenate([b_i, b_f], axis=-1),
        "conv_qk": nrm(ks[6], (DEPTH, CONV_WIDTH, 2 * MLSTM_WIDTH), CONV_WIDTH ** -0.5),
        "g_mlstm": 1.0 + nrm(ks[7], (DEPTH, MLSTM_WIDTH), 0.02),
        "hg_lb": nrm(ks[8], (DEPTH + 1, HGRN_WIDTH), 0.5),
        "g_hgrn": 1.0 + nrm(ks[9], (DEPTH, HGRN_HEAD_DIM), 0.02),
        "w_out": nrm(ks[10], (DEPTH, D_MIX, D_MODEL), D_MIX ** -0.5),
        "g_ffn": 1.0 + nrm(ks[11], (DEPTH, D_MODEL), 0.02),
        "w_rg": nrm(ks[12], (DEPTH, D_MODEL, N_GROUPS), D_MODEL ** -0.5),
        "b_rg": nrm(ks[13], (DEPTH, N_GROUPS), 0.01),
        "w_re": nrm(ks[14], (DEPTH, D_MODEL, N_EXPERTS), D_MODEL ** -0.5),
        "b_re": nrm(ks[15], (DEPTH, N_EXPERTS), 0.01),
        "w_e_gate": nrm(ks[16], (DEPTH, N_EXPERTS, D_MODEL, D_EXPERT), D_MODEL ** -0.5),
        "w_e_up": nrm(ks[17], (DEPTH, N_EXPERTS, D_MODEL, D_EXPERT), D_MODEL ** -0.5),
        "w_e_down": nrm(ks[18], (DEPTH, N_EXPERTS, D_EXPERT, D_MODEL), D_EXPERT ** -0.5),
        "g_pl": 1.0 + nrm(ks[19], (DEPTH, D_MODEL), 0.02),
        "w_pl_gate": nrm(ks[20], (DEPTH, D_MODEL, D_MODEL), D_MODEL ** -0.5),
        "w_pl_proj": nrm(ks[21], (DEPTH, PLE_DIM, D_MODEL), PLE_DIM ** -0.5),
        "g_final": 1.0 + nrm(ks[22], (D_MODEL,), 0.02),
    }


def reference(x, p, g_mix, w_in, b_mgate, conv_qk, g_mlstm, hg_lb, g_hgrn, w_out, g_ffn,
              w_rg, b_rg, w_re, b_re, w_e_gate, w_e_up, w_e_down, g_pl, w_pl_gate, w_pl_proj, g_final):
    lower_bounds = jnp.cumsum(jax.nn.softmax(hg_lb.astype(jnp.float32), axis=0), axis=0)
    w = MLSTM_WIDTH
    for i in range(DEPTH):
        h = rms_norm(x, g_mix[i])
        z = h @ w_in[i]
        gate_pre = z[..., 4 * w:MLSTM_COLS].astype(jnp.float32) + b_mgate[i].astype(jnp.float32)
        y_m = mlstm_mixer(z[..., :2 * w], z[..., 2 * w:3 * w], z[..., 3 * w:4 * w], gate_pre,
                          conv_qk[i], g_mlstm[i])
        o = MLSTM_COLS
        y_h = hgrn2_mixer(z[..., o:o + HGRN_WIDTH], z[..., o + HGRN_WIDTH:o + 2 * HGRN_WIDTH],
                          z[..., o + 2 * HGRN_WIDTH:o + 3 * HGRN_WIDTH], z[..., o + 3 * HGRN_WIDTH:o + 4 * HGRN_WIDTH],
                          lower_bounds[i], g_hgrn[i])
        x = x + jnp.concatenate([y_m, y_h], axis=-1) @ w_out[i]
        x = x + hier_moe(rms_norm(x, g_ffn[i]), w_rg[i], b_rg[i], w_re[i], b_re[i],
                         w_e_gate[i], w_e_up[i], w_e_down[i])
        x = x + jax.nn.sigmoid(rms_norm(x, g_pl[i]) @ w_pl_gate[i]) * (p[i] @ w_pl_proj[i])
    return rms_norm(x, g_final)
```

```cpp
#include <hip/hip_runtime.h>
#include <cstdio>
#include <cstdint>

#ifndef MK_N_LAUNCHES
#define MK_N_LAUNCHES 10
#endif

#define GAS __attribute__((address_space(1)))
#define LAS __attribute__((address_space(3)))
typedef unsigned short bf16;
typedef unsigned v4u __attribute__((ext_vector_type(4)));
typedef unsigned v2u __attribute__((ext_vector_type(2)));
typedef float f32x4 __attribute__((ext_vector_type(4)));
typedef float f32x2 __attribute__((ext_vector_type(2)));

constexpr int D = 1024, NBATCH = 16, T = 2048, M = NBATCH * T, PLE = 256;
constexpr int W = 512, NH = 4, HD = 128;
constexpr int INC = 4104, ZC = 4096;
constexpr int NE = 32, NG = 4, EPG = 8, DE = 512;
constexpr float EPS = 1e-6f;
constexpr int NWAVES = 8, NTHR = 512;
constexpr int PER_PHASE = 10;
constexpr int N_LAUNCHES = MK_N_LAUNCHES;

constexpr size_t MiB = 1u << 20;
constexpr size_t WS_CTL = 0, CTL_ZERO_BYTES = 1 * MiB;
constexpr size_t WS_WIN = 1 * MiB;
constexpr size_t WS_WOUT = 9 * MiB;
constexpr size_t WS_WPLG = 11 * MiB;
constexpr size_t WS_WPLP = 13 * MiB;
constexpr size_t WS_WGU = 14 * MiB;
constexpr size_t WS_WD = 78 * MiB;
constexpr size_t WS_LB = 110 * MiB;
constexpr size_t WS_GP = 111 * MiB;
constexpr size_t WS_TOKI = 112 * MiB;
constexpr size_t WS_TOKW = 112 * MiB + 640 * 1024;
constexpr size_t WS_HN = 113 * MiB;
constexpr size_t WS_Y = 177 * MiB;
constexpr size_t WS_Z = 241 * MiB;
constexpr size_t WS_HID = WS_Z;
constexpr size_t WS_YB = WS_Z + 76 * MiB;
constexpr size_t WS_LIST = WS_Z + 224 * MiB;
constexpr size_t WS_PB = WS_Z + 232 * MiB;
constexpr size_t WS_END = 497 * MiB;

constexpr int CW_CNT = 64;
constexpr int CW_BAR = 4096;

constexpr int LDS_BYTES = 155648;

__device__ __forceinline__ float bf2f(bf16 b) { return __uint_as_float(((unsigned)b) << 16); }
__device__ __forceinline__ unsigned f2bf(float f) { unsigned u = __float_as_uint(f); return (u + 0x7fffu + ((u >> 16) & 1u)) >> 16; }
__device__ __forceinline__ unsigned pk2(float lo, float hi) { return f2bf(lo) | (f2bf(hi) << 16); }
__device__ __forceinline__ float wave_sum(float v) {
#pragma unroll
    for (int o = 1; o < 64; o <<= 1) v += __shfl_xor(v, o);
    return v;
}
__device__ __forceinline__ float sigmoidf_(float x) { return 1.0f / (1.0f + __expf(-x)); }
__device__ __forceinline__ float siluf_(float x) { return x / (1.0f + __expf(-x)); }
__device__ __forceinline__ float logsigmoidf_(float x) { return fminf(x, 0.f) - log1pf(__expf(-fabsf(x))); }

struct Args { const float* in[22]; float* out; unsigned char* ws; int ph_lo, ph_hi; };

__device__ __forceinline__ void tr_item(const float* src, int ld, int k0, int nsrc0, bf16* dst, int Kd, int ndst0, LAS float* scr, int lane) {
#pragma unroll 8
    for (int i = 0; i < 32; ++i) { const int kk = 2 * i + (lane >> 5); scr[kk * 33 + (lane & 31)] = src[(size_t)(k0 + kk) * ld + nsrc0 + (lane & 31)]; }
    asm volatile("s_waitcnt lgkmcnt(0)" ::: "memory");
    const int c = lane & 7;
#pragma unroll
    for (int j = 0; j < 4; ++j) {
        const int n = (lane >> 3) + 8 * j; const LAS float* s = scr + (8 * c) * 33 + n;
        v4u o; o.x = pk2(s[0 * 33], s[1 * 33]); o.y = pk2(s[2 * 33], s[3 * 33]); o.z = pk2(s[4 * 33], s[5 * 33]); o.w = pk2(s[6 * 33], s[7 * 33]);
        *(v4u*)(dst + (size_t)(ndst0 + n) * Kd + k0 + 8 * c) = o;
    }
    asm volatile("s_waitcnt lgkmcnt(0)" ::: "memory");
}

__device__ __forceinline__ void p0_prologue(const Args& a, LAS unsigned char* lds) {
    const int tid = threadIdx.x, lane = tid & 63, wave = tid >> 6, G = gridDim.x;
    unsigned char* ws = a.ws;
    LAS float* wg = (LAS float*)lds;
    LAS float* scr = (LAS float*)(lds + 32768 + wave * 8704);
    {
        const float* w_in = a.in[3];
        for (int i = tid; i < 8 * 1024; i += NTHR) { const int k = i >> 3, j = i & 7; wg[j * 1024 + k] = w_in[(size_t)k * INC + 2048 + j]; }
    }
    __syncthreads();
    const int gw = blockIdx.x * NWAVES + wave, NGW = G * NWAVES;
    constexpr int I_WIN = 16 * 128, I_SQ = 16 * 32, I_PLP = 4 * 32, I_GU = 16 * 32, I_D = 8 * 32;
    constexpr int NITEMS = I_WIN + 2 * I_SQ + I_PLP + NE * I_GU + NE * I_D;
    for (int it = gw; it < NITEMS; it += NGW) {
        int r = it;
        if (r < I_WIN) { const int kb = r / 128, nb = r % 128; const int nd = nb * 32; const int ns = nd < 2048 ? nd : nd + 8;
            tr_item(a.in[3], INC, kb * 64, ns, (bf16*)(ws + WS_WIN), D, nd, scr, lane); continue; }
        r -= I_WIN;
        if (r < I_SQ) { const int kb = r / 32, nb = r % 32; tr_item(a.in[9], D, kb * 64, nb * 32, (bf16*)(ws + WS_WOUT), D, nb * 32, scr, lane); continue; }
        r -= I_SQ;
        if (r < I_SQ) { const int kb = r / 32, nb = r % 32; tr_item(a.in[19], D, kb * 64, nb * 32, (bf16*)(ws + WS_WPLG), D, nb * 32, scr, lane); continue; }
        r -= I_SQ;
        if (r < I_PLP) { const int kb = r / 32, nb = r % 32; tr_item(a.in[20], D, kb * 64, nb * 32, (bf16*)(ws + WS_WPLP), PLE, nb * 32, scr, lane); continue; }
        r -= I_PLP;
        if (r < NE * I_GU) { const int e = r / I_GU, q = r % I_GU, kb = q / 32, nb = q % 32;
            const int nd = nb * 32, tile = nd >> 8, half = (nd >> 7) & 1, r0 = nd & 127;
            const float* src = (half ? a.in[16] : a.in[15]) + (size_t)e * D * DE;
            tr_item(src, DE, kb * 64, tile * 128 + r0, (bf16*)(ws + WS_WGU) + (size_t)e * 1024 * 1024, D, nd, scr, lane); continue; }
        r -= NE * I_GU;
        { const int e = r / I_D, q = r % I_D, kb = q / 32, nb = q % 32;
            tr_item(a.in[17] + (size_t)e * DE * D, D, kb * 64, nb * 32, (bf16*)(ws + WS_WD) + (size_t)e * 1024 * 512, DE, nb * 32, scr, lane); }
    }
    if (blockIdx.x == 0) {
        const float* hl = a.in[7]; float* lb = (float*)(ws + WS_LB);
        for (int c = tid; c < W; c += NTHR) { const float a0 = hl[c], a1 = hl[W + c], mx = fmaxf(a0, a1); const float e0 = __expf(a0 - mx), e1 = __expf(a1 - mx); lb[c] = e0 / (e0 + e1); }
    }
    const float* x = a.in[0]; const float* g = a.in[2]; const float* bm = a.in[4];
    bf16* HN = (bf16*)(ws + WS_HN); float* GP = (float*)(ws + WS_GP);
    f32x4 gv[4];
#pragma unroll
    for (int j = 0; j < 4; ++j) gv[j] = *(const f32x4*)(g + 4 * lane + 256 * j);
    for (int m = gw; m < M; m += NGW) {
        const f32x4* xr = (const f32x4*)(x + (size_t)m * D) + lane;
        f32x4 v[4]; float ss = 0.f;
#pragma unroll
        for (int j = 0; j < 4; ++j) { v[j] = xr[64 * j]; ss += (v[j].x * v[j].x + v[j].y * v[j].y) + (v[j].z * v[j].z + v[j].w * v[j].w); }
        const float rstd = rsqrtf(wave_sum(ss) * (1.f / D) + EPS);
#pragma unroll
        for (int j = 0; j < 4; ++j) v[j] = v[j] * rstd * gv[j];
        unsigned long long* o8 = (unsigned long long*)(HN + (size_t)m * D) + lane;
#pragma unroll
        for (int j = 0; j < 4; ++j) o8[64 * j] = (unsigned long long)pk2(v[j].x, v[j].y) | ((unsigned long long)pk2(v[j].z, v[j].w) << 32);
        float gs[8];
#pragma unroll
        for (int q = 0; q < 8; ++q) {
            float s = 0.f;
#pragma unroll
            for (int j = 0; j < 4; ++j) { const f32x4 wv = *(const LAS f32x4*)(wg + q * 1024 + 4 * lane + 256 * j); s += (v[j].x * wv.x + v[j].y * wv.y) + (v[j].z * wv.z + v[j].w * wv.w); }
            gs[q] = wave_sum(s);
        }
        if (lane == 0) {
            f32x4 o0 = {gs[0] + bm[0], gs[1] + bm[1], gs[2] + bm[2], gs[3] + bm[3]}, o1 = {gs[4] + bm[4], gs[5] + bm[5], gs[6] + bm[6], gs[7] + bm[7]};
            *(f32x4*)(GP + (size_t)m * 8) = o0; *(f32x4*)(GP + (size_t)m * 8 + 4) = o1;
        }
    }
}

template <class AF, class BF, class EF>
__device__ __forceinline__ void naive_gemm(LAS unsigned char* lds, int nrt, int nct, int K, const AF& af, const BF& bfn, const EF& ef) {
    LAS float* As = (LAS float*)lds; LAS float* Bs = As + 64 * 33;
    const int tid = threadIdx.x, r = tid >> 3, c0 = (tid & 7) * 8;
    for (int tile = blockIdx.x; tile < nrt * nct; tile += gridDim.x) {
        const int tm = tile / nct, tn = tile % nct;
        float acc[8];
#pragma unroll
        for (int j = 0; j < 8; ++j) acc[j] = 0.f;
        for (int k0 = 0; k0 < K; k0 += 32) {
            __syncthreads();
#pragma unroll
            for (int i = 0; i < 4; ++i) { const int idx = tid + NTHR * i, rr = idx >> 5, kk = idx & 31;
                As[rr * 33 + kk] = bf2f(af(tm * 64 + rr)[k0 + kk]); Bs[rr * 33 + kk] = bf2f(bfn(tn * 64 + rr, tm * 64)[k0 + kk]); }
            __syncthreads();
#pragma unroll 8
            for (int kk = 0; kk < 32; ++kk) { const float av = As[r * 33 + kk];
#pragma unroll
                for (int j = 0; j < 8; ++j) acc[j] += av * Bs[(c0 + j) * 33 + kk]; }
        }
#pragma unroll
        for (int j = 0; j < 8; ++j) ef(tm * 64 + r, tn * 64 + c0 + j, acc[j]);
    }
}

struct AF_plain { const bf16* A; int K; __device__ __forceinline__ const bf16* operator()(int r) const { return A + (size_t)r * K; } };
struct BF_plain { const bf16* B; int K; __device__ __forceinline__ const bf16* operator()(int c, int) const { return B + (size_t)c * K; } };
struct EF_bf16 { bf16* O; int ld; __device__ __forceinline__ void operator()(int r, int c, float v) const { O[(size_t)r * ld + c] = (bf16)f2bf(v); } };
struct EF_resid { const float* X; float* O; __device__ __forceinline__ void operator()(int r, int c, float v) const { O[(size_t)r * D + c] = X[(size_t)r * D + c] + v; } };
struct EF_ple { float* O; const bf16* P; __device__ __forceinline__ void operator()(int r, int c, float v) const { const size_t i = (size_t)r * D + c; O[i] = O[i] + sigmoidf_(v) * bf2f(P[i]); } };

constexpr int TB = 32;
__device__ __forceinline__ void naive_mlstm_unit(const Args& a, LAS unsigned char* lds, int b, int h) {
    const int tid = threadIdx.x, lane = tid & 63, wave = tid >> 6, e = tid & 127, dq = tid >> 7;
    const bf16* Z = (const bf16*)(a.ws + WS_Z); const float* GP = (const float*)(a.ws + WS_GP); bf16* Y = (bf16*)(a.ws + WS_Y);
    const float* convw = a.in[5]; const float* gn = a.in[6];
    LAS float* qs = (LAS float*)lds;
    LAS float* ks = qs + TB * 128;
    LAS float* vs = ks + TB * 128;
    LAS float* os = vs + TB * 128;
    LAS float* hs = os + TB * 128;
    LAS float* gi = hs + TB * 128;
    LAS float* gf = gi + TB;
    LAS float* red = gf + TB;
    LAS float* red2 = red + 2 * 4 * 128;
    float C[32], n[32];
#pragma unroll
    for (int j = 0; j < 32; ++j) { C[j] = 0.f; n[j] = 0.f; }
    float mst = 0.f;
    const float kscale = 0.08838834764831845f;
    for (int t0 = 0; t0 < T; t0 += TB) {
        __syncthreads();
        for (int i = tid; i < TB * 128; i += NTHR) {
            const int tt = i >> 7, c = i & 127, t = t0 + tt; const size_t row = (size_t)(b * T + t);
            float sq = 0.f, sk = 0.f;
#pragma unroll
            for (int j = 0; j < 4; ++j) { const int ts = t - 3 + j; if (ts >= 0) { const size_t rs = (size_t)(b * T + ts) * ZC;
                sq += convw[j * 1024 + h * 128 + c] * bf2f(Z[rs + h * 128 + c]); sk += convw[j * 1024 + 512 + h * 128 + c] * bf2f(Z[rs + 512 + h * 128 + c]); } }
            qs[i] = siluf_(sq); ks[i] = siluf_(sk) * kscale;
            vs[i] = bf2f(Z[row * ZC + 1024 + h * 128 + c]); os[i] = sigmoidf_(bf2f(Z[row * ZC + 1536 + h * 128 + c]));
        }
        if (tid < TB) { const size_t row = (size_t)(b * T + t0 + tid); gi[tid] = GP[row * 8 + h]; gf[tid] = logsigmoidf_(GP[row * 8 + 4 + h]); }
        __syncthreads();
        for (int tt = 0; tt < TB; ++tt) {
            const float ig = gi[tt], lf = gf[tt];
            const float mnew = fmaxf(lf + mst, ig), fg = __expf(lf + mst - mnew), iw = __expf(ig - mnew);
            mst = mnew;
            const float ve = vs[tt * 128 + e];
            float pn = 0.f, pd = 0.f;
#pragma unroll
            for (int j = 0; j < 32; ++j) { const float kd = ks[tt * 128 + dq * 32 + j] * iw, qd = qs[tt * 128 + dq * 32 + j];
                C[j] = fg * C[j] + kd * ve; n[j] = fg * n[j] + kd; pn += C[j] * qd; pd += n[j] * qd; }
            LAS float* rd = red + (tt & 1) * 512; LAS float* rd2 = red2 + (tt & 1) * 4;
            rd[dq * 128 + e] = pn; if (e == 0) rd2[dq] = pd;
            __syncthreads();
            if (tid < 128) {
                const float num = (rd[e] + rd[128 + e]) + (rd[256 + e] + rd[384 + e]);
                const float den = (rd2[0] + rd2[1]) + (rd2[2] + rd2[3]);
                const float hv = num / fmaxf(fabsf(den), __expf(-mnew));
                hs[tt * 128 + e] = hv * os[tt * 128 + e];
            }
        }
        __syncthreads();
        for (int tt = wave; tt < TB; tt += NWAVES) {
            const float h0 = hs[tt * 128 + lane], h1 = hs[tt * 128 + 64 + lane];
            const float rs = rsqrtf(wave_sum(h0 * h0 + h1 * h1) * (1.f / 128.f) + EPS);
            const size_t row = (size_t)(b * T + t0 + tt);
            Y[row * D + h * 128 + lane] = (bf16)f2bf(h0 * rs * gn[h * 128 + lane]);
            Y[row * D + h * 128 + 64 + lane] = (bf16)f2bf(h1 * rs * gn[h * 128 + 64 + lane]);
        }
    }
}

__device__ __forceinline__ void naive_hgrn_unit(const Args& a, LAS unsigned char* lds, int b, int h) {
    const int tid = threadIdx.x, lane = tid & 63, wave = tid >> 6, e = tid & 127, dq = tid >> 7;
    const bf16* Z = (const bf16*)(a.ws + WS_Z); const float* LB = (const float*)(a.ws + WS_LB); bf16* Y = (bf16*)(a.ws + WS_Y);
    const float* gn = a.in[8];
    LAS float* qs = (LAS float*)lds;
    LAS float* fs = qs + TB * 128;
    LAS float* ks = fs + TB * 128;
    LAS float* vs = ks + TB * 128;
    LAS float* gs = vs + TB * 128;
    LAS float* hs = gs + TB * 128;
    LAS float* red = hs + TB * 128;
    float S[32];
#pragma unroll
    for (int j = 0; j < 32; ++j) S[j] = 0.f;
    for (int t0 = 0; t0 < T; t0 += TB) {
        __syncthreads();
        for (int i = tid; i < TB * 128; i += NTHR) {
            const int tt = i >> 7, c = i & 127; const size_t row = (size_t)(b * T + t0 + tt) * ZC;
            const float lbv = LB[h * 128 + c];
            const float qp = bf2f(Z[row + 2048 + h * 128 + c]), fp = bf2f(Z[row + 2560 + h * 128 + c]);
            qs[i] = siluf_(qp); fs[i] = lbv + (1.f - lbv) * sigmoidf_(fp); ks[i] = (1.f - lbv) * sigmoidf_(-fp);
            vs[i] = bf2f(Z[row + 3072 + h * 128 + c]); gs[i] = siluf_(bf2f(Z[row + 3584 + h * 128 + c]));
        }
        __syncthreads();
        for (int tt = 0; tt < TB; ++tt) {
            const float ve = vs[tt * 128 + e];
            float pn = 0.f;
#pragma unroll
            for (int j = 0; j < 32; ++j) { const int d = tt * 128 + dq * 32 + j; S[j] = fs[d] * S[j] + ks[d] * ve; pn += S[j] * qs[d]; }
            LAS float* rd = red + (tt & 1) * 512;
            rd[dq * 128 + e] = pn;
            __syncthreads();
            if (tid < 128) hs[tt * 128 + e] = (rd[e] + rd[128 + e]) + (rd[256 + e] + rd[384 + e]);
        }
        __syncthreads();
        for (int tt = wave; tt < TB; tt += NWAVES) {
            const float h0 = hs[tt * 128 + lane], h1 = hs[tt * 128 + 64 + lane];
            const float rs = rsqrtf(wave_sum(h0 * h0 + h1 * h1) * (1.f / 128.f) + EPS);
            const size_t row = (size_t)(b * T + t0 + tt);
            Y[row * D + W + h * 128 + lane] = (bf16)f2bf(h0 * rs * gn[lane] * gs[tt * 128 + lane]);
            Y[row * D + W + h * 128 + 64 + lane] = (bf16)f2bf(h1 * rs * gn[64 + lane] * gs[tt * 128 + 64 + lane]);
        }
    }
}

__device__ __forceinline__ void p2_mixers(const Args& a, LAS unsigned char* lds) {
    for (int u = blockIdx.x; u < 128; u += gridDim.x) {
        if (u < 64) naive_mlstm_unit(a, lds, u >> 2, u & 3);
        else naive_hgrn_unit(a, lds, (u - 64) >> 2, (u - 64) & 3);
    }
}

__device__ __forceinline__ void p4_router(const Args& a, LAS unsigned char* lds) {
    const int tid = threadIdx.x, lane = tid & 63, wave = tid >> 6, G = gridDim.x;
    unsigned char* ws = a.ws;
    LAS float* wr = (LAS float*)lds;
    LAS int* hist = (LAS int*)(lds + 147456);
    LAS int* base = hist + 32;
    LAS int* rowE = base + 32;
    LAS int* rowP = rowE + 256;
    {
        const float* w_rg = a.in[11]; const float* w_re = a.in[13];
        for (int i = tid; i < 4 * 1024; i += NTHR) { const int k = i >> 2, j = i & 3; wr[j * 1024 + k] = w_rg[i]; }
        for (int i = tid; i < 32 * 1024; i += NTHR) { const int k = i >> 5, j = i & 31; wr[(4 + j) * 1024 + k] = w_re[i]; }
        if (tid < 32) hist[tid] = 0;
    }
    __syncthreads();
    const float* x1 = a.out; const float* g = a.in[10]; const float* b_rg = a.in[12]; const float* b_re = a.in[14];
    bf16* HN = (bf16*)(ws + WS_HN);
    int* cnt = (int*)(ws + WS_CTL) + CW_CNT; int* list = (int*)(ws + WS_LIST);
    int4* toki = (int4*)(ws + WS_TOKI); float2* tokw = (float2*)(ws + WS_TOKW);
    f32x4 gv[4];
#pragma unroll
    for (int j = 0; j < 4; ++j) gv[j] = *(const f32x4*)(g + 4 * lane + 256 * j);
    for (int rb = blockIdx.x; rb < M / 128; rb += G) {
        for (int rr = 0; rr < 16; ++rr) {
            const int lr = wave * 16 + rr, m = rb * 128 + lr;
            const f32x4* xr = (const f32x4*)(x1 + (size_t)m * D) + lane;
            f32x4 v[4]; float ss = 0.f;
#pragma unroll
            for (int j = 0; j < 4; ++j) { v[j] = xr[64 * j]; ss += (v[j].x * v[j].x + v[j].y * v[j].y) + (v[j].z * v[j].z + v[j].w * v[j].w); }
            const float rstd = rsqrtf(wave_sum(ss) * (1.f / D) + EPS);
#pragma unroll
            for (int j = 0; j < 4; ++j) v[j] = v[j] * rstd * gv[j];
            unsigned long long* o8 = (unsigned long long*)(HN + (size_t)m * D) + lane;
#pragma unroll
            for (int j = 0; j < 4; ++j) o8[64 * j] = (unsigned long long)pk2(v[j].x, v[j].y) | ((unsigned long long)pk2(v[j].z, v[j].w) << 32);
            float gl[4];
#pragma unroll
            for (int q = 0; q < 4; ++q) { float s = 0.f;
#pragma unroll
                for (int j = 0; j < 4; ++j) { const f32x4 wv = *(const LAS f32x4*)(wr + q * 1024 + 4 * lane + 256 * j); s += (v[j].x * wv.x + v[j].y * wv.y) + (v[j].z * wv.z + v[j].w * wv.w); }
                gl[q] = wave_sum(s) + b_rg[q]; }
            int gsel = 0; float gmax = gl[0];
#pragma unroll
            for (int q = 1; q < 4; ++q) if (gl[q] > gmax) { gmax = gl[q]; gsel = q; }
            float gsum = 0.f;
#pragma unroll
            for (int q = 0; q < 4; ++q) gsum += __expf(gl[q] - gmax);
            const float gval = 1.f / gsum;
            float el[8];
#pragma unroll
            for (int q = 0; q < 8; ++q) { float s = 0.f; const LAS float* wrow = wr + (4 + gsel * 8 + q) * 1024;
#pragma unroll
                for (int j = 0; j < 4; ++j) { const f32x4 wv = *(const LAS f32x4*)(wrow + 4 * lane + 256 * j); s += (v[j].x * wv.x + v[j].y * wv.y) + (v[j].z * wv.z + v[j].w * wv.w); }
                el[q] = wave_sum(s) + b_re[gsel * 8 + q]; }
            int i0 = 0; float v0 = el[0];
#pragma unroll
            for (int q = 1; q < 8; ++q) if (el[q] > v0) { v0 = el[q]; i0 = q; }
            int i1 = -1; float v1 = -3.0e38f;
#pragma unroll
            for (int q = 0; q < 8; ++q) if (q != i0 && el[q] > v1) { v1 = el[q]; i1 = q; }
            if (lane == 0) {
                const float p1 = 1.f / (1.f + __expf(v0 - v1));
                const float p0 = 1.f - p1;
                const int e0 = gsel * 8 + i0, e1 = gsel * 8 + i1;
                rowE[lr * 2] = e0; rowE[lr * 2 + 1] = e1;
                rowP[lr * 2] = __hip_atomic_fetch_add(&hist[e0], 1, __ATOMIC_RELAXED, __HIP_MEMORY_SCOPE_WORKGROUP); rowP[lr * 2 + 1] = __hip_atomic_fetch_add(&hist[e1], 1, __ATOMIC_RELAXED, __HIP_MEMORY_SCOPE_WORKGROUP);
                tokw[m] = make_float2(p0 * gval, p1 * gval);
            }
        }
        __syncthreads();
        if (tid < 32) { const int c = hist[tid]; base[tid] = c ? atomicAdd(&cnt[tid], c) : 0; }
        __syncthreads();
        if (tid < 128) {
            const int m = rb * 128 + tid, e0 = rowE[tid * 2], e1 = rowE[tid * 2 + 1];
            const int q0 = base[e0] + rowP[tid * 2], q1 = base[e1] + rowP[tid * 2 + 1];
            toki[m] = make_int4(e0, e1, q0, q1);
            list[e0 * M + q0] = m; list[e1 * M + q1] = m;
        }
        __syncthreads();
        if (tid < 32) hist[tid] = 0;
        __syncthreads();
    }
    {
        const f32x4* p4 = (const f32x4*)a.in[1]; v2u* pb = (v2u*)(ws + WS_PB);
        const size_t n4 = (size_t)M * PLE / 4;
        for (size_t i = (size_t)blockIdx.x * NTHR + tid; i < n4; i += (size_t)G * NTHR) { const f32x4 v = p4[i]; v2u o; o.x = pk2(v.x, v.y); o.y = pk2(v.z, v.w); pb[i] = o; }
    }
}

__device__ __forceinline__ void load_pstart(const Args& a, LAS int* ps, LAS int* cn) {
    if (threadIdx.x == 0) {
        const int* cnt = (const int*)(a.ws + WS_CTL) + CW_CNT; int s = 0;
        for (int e = 0; e < NE; ++e) { const int c = __hip_atomic_load(cnt + e, __ATOMIC_RELAXED, __HIP_MEMORY_SCOPE_AGENT); cn[e] = c; ps[e] = s; s += (c + 255) & ~255; }
        ps[NE] = s;
    }
    __syncthreads();
}

__device__ __forceinline__ void p5_moe_up_naive(const Args& a, LAS unsigned char* lds) {
    LAS int* ps = (LAS int*)(lds + 65536); LAS int* cn = ps + 40;
    load_pstart(a, ps, cn);
    LAS float* As = (LAS float*)lds; LAS float* Bg = As + 64 * 33; LAS float* Bu = Bg + 64 * 33;
    const bf16* HN = (const bf16*)(a.ws + WS_HN); const bf16* WGU = (const bf16*)(a.ws + WS_WGU); bf16* HID = (bf16*)(a.ws + WS_HID);
    const int* list = (const int*)(a.ws + WS_LIST);
    const int tid = threadIdx.x, r = tid >> 3, c0 = (tid & 7) * 8;
    const int nrt = ps[NE] / 64;
    for (int u = blockIdx.x; u < nrt * 8; u += gridDim.x) {
        const int rt = u >> 3, ct = u & 7, row0 = rt * 64;
        int e = 0;
        for (int q = 1; q < NE; ++q) if (ps[q] <= row0) e = q;
        const int pos0 = row0 - ps[e], cnt_e = cn[e];
        float ag[8], au[8];
#pragma unroll
        for (int j = 0; j < 8; ++j) { ag[j] = 0.f; au[j] = 0.f; }
        for (int k0 = 0; k0 < D; k0 += 32) {
            __syncthreads();
#pragma unroll
            for (int i = 0; i < 4; ++i) { const int idx = tid + NTHR * i, rr = idx >> 5, kk = idx & 31;
                const int pos = pos0 + rr; const int tok = pos < cnt_e ? list[e * M + pos] : 0;
                As[rr * 33 + kk] = bf2f(HN[(size_t)tok * D + k0 + kk]);
                const int hc = ct * 64 + rr; const size_t brow = (size_t)e * 1024 + (hc >> 7) * 256 + (hc & 127);
                Bg[rr * 33 + kk] = bf2f(WGU[brow * D + k0 + kk]); Bu[rr * 33 + kk] = bf2f(WGU[(brow + 128) * D + k0 + kk]); }
            __syncthreads();
#pragma unroll 4
            for (int kk = 0; kk < 32; ++kk) { const float av = As[r * 33 + kk];
#pragma unroll
                for (int j = 0; j < 8; ++j) { ag[j] += av * Bg[(c0 + j) * 33 + kk]; au[j] += av * Bu[(c0 + j) * 33 + kk]; } }
        }
#pragma unroll
        for (int j = 0; j < 8; ++j) HID[(size_t)(row0 + r) * DE + ct * 64 + c0 + j] = (bf16)f2bf(siluf_(ag[j]) * au[j]);
    }
}

struct BF_down { const bf16* B; const LAS int* ps; __device__ __forceinline__ const bf16* operator()(int c, int row0) const {
    int e = 0; for (int q = 1; q < NE; ++q) if (ps[q] <= row0) e = q; return B + ((size_t)e * 1024 + c) * DE; } };
__device__ __forceinline__ void p6_moe_down_naive(const Args& a, LAS unsigned char* lds) {
    LAS int* ps = (LAS int*)(lds + 65536); LAS int* cn = ps + 40;
    load_pstart(a, ps, cn);
    const int nrt = ps[NE] / 64;
    naive_gemm(lds, nrt, 16, DE, AF_plain{(const bf16*)(a.ws + WS_HID), DE}, BF_down{(const bf16*)(a.ws + WS_WD), ps}, EF_bf16{(bf16*)(a.ws + WS_YB), D});
    naive_gemm(lds, M / 64, 16, PLE, AF_plain{(const bf16*)(a.ws + WS_PB), PLE}, BF_plain{(const bf16*)(a.ws + WS_WPLP), PLE}, EF_bf16{(bf16*)(a.ws + WS_Y), D});
}

__device__ __forceinline__ void p7_combine(const Args& a, LAS unsigned char* lds) {
    LAS int* ps = (LAS int*)lds; LAS int* cn = ps + 40;
    load_pstart(a, ps, cn);
    const int tid = threadIdx.x, lane = tid & 63, wave = tid >> 6;
    const int gw = blockIdx.x * NWAVES + wave, NGW = gridDim.x * NWAVES;
    float* xo = a.out; const float* g = a.in[18]; const bf16* YB = (const bf16*)(a.ws + WS_YB); bf16* HN = (bf16*)(a.ws + WS_HN);
    const int4* toki = (const int4*)(a.ws + WS_TOKI); const float2* tokw = (const float2*)(a.ws + WS_TOKW);
    f32x4 gv[4];
#pragma unroll
    for (int j = 0; j < 4; ++j) gv[j] = *(const f32x4*)(g + 4 * lane + 256 * j);
    for (int m = gw; m < M; m += NGW) {
        const int4 ti = toki[m]; const float2 tw = tokw[m];
        const size_t r0 = (size_t)(ps[ti.x] + ti.z), r1 = (size_t)(ps[ti.y] + ti.w);
        f32x4* xr = (f32x4*)(xo + (size_t)m * D) + lane;
        const v2u* y0 = (const v2u*)(YB + r0 * D) + lane; const v2u* y1 = (const v2u*)(YB + r1 * D) + lane;
        f32x4 v[4]; float ss = 0.f;
#pragma unroll
        for (int j = 0; j < 4; ++j) {
            v[j] = xr[64 * j]; const v2u a0 = y0[64 * j], a1 = y1[64 * j];
            v[j].x += tw.x * __uint_as_float(a0.x << 16) + tw.y * __uint_as_float(a1.x << 16);
            v[j].y += tw.x * __uint_as_float(a0.x & 0xffff0000u) + tw.y * __uint_as_float(a1.x & 0xffff0000u);
            v[j].z += tw.x * __uint_as_float(a0.y << 16) + tw.y * __uint_as_float(a1.y << 16);
            v[j].w += tw.x * __uint_as_float(a0.y & 0xffff0000u) + tw.y * __uint_as_float(a1.y & 0xffff0000u);
            xr[64 * j] = v[j];
            ss += (v[j].x * v[j].x + v[j].y * v[j].y) + (v[j].z * v[j].z + v[j].w * v[j].w);
        }
        const float rstd = rsqrtf(wave_sum(ss) * (1.f / D) + EPS);
        unsigned long long* o8 = (unsigned long long*)(HN + (size_t)m * D) + lane;
#pragma unroll
        for (int j = 0; j < 4; ++j) { const f32x4 hv = v[j] * rstd * gv[j]; o8[64 * j] = (unsigned long long)pk2(hv.x, hv.y) | ((unsigned long long)pk2(hv.z, hv.w) << 32); }
    }
}

__device__ __forceinline__ void p9_final(const Args& a) {
    const int tid = threadIdx.x, lane = tid & 63, wave = tid >> 6;
    const int gw = blockIdx.x * NWAVES + wave, NGW = gridDim.x * NWAVES;
    float* xo = a.out; const float* g = a.in[21];
    f32x4 gv[4];
#pragma unroll
    for (int j = 0; j < 4; ++j) gv[j] = *(const f32x4*)(g + 4 * lane + 256 * j);
    for (int m = gw; m < M; m += NGW) {
        f32x4* xr = (f32x4*)(xo + (size_t)m * D) + lane;
        f32x4 v[4]; float ss = 0.f;
#pragma unroll
        for (int j = 0; j < 4; ++j) { v[j] = xr[64 * j]; ss += (v[j].x * v[j].x + v[j].y * v[j].y) + (v[j].z * v[j].z + v[j].w * v[j].w); }
        const float rstd = rsqrtf(wave_sum(ss) * (1.f / D) + EPS);
#pragma unroll
        for (int j = 0; j < 4; ++j) xr[64 * j] = v[j] * rstd * gv[j];
    }
}

__global__ void __launch_bounds__(NTHR, 2) fwd(Args args) {
    extern __shared__ __attribute__((aligned(16))) unsigned char lds_raw[];
    LAS unsigned char* lds = (LAS unsigned char*)lds_raw;
    const int lo = args.ph_lo, hi = args.ph_hi;
#define IN(k) (lo <= (k) && (k) < hi)
    if (IN(0)) { p0_prologue(args, lds); }
    if (IN(1)) { naive_gemm(lds, M / 64, ZC / 64, D, AF_plain{(const bf16*)(args.ws + WS_HN), D}, BF_plain{(const bf16*)(args.ws + WS_WIN), D}, EF_bf16{(bf16*)(args.ws + WS_Z), ZC}); }
    if (IN(2)) { p2_mixers(args, lds); }
    if (IN(3)) { naive_gemm(lds, M / 64, D / 64, D, AF_plain{(const bf16*)(args.ws + WS_Y), D}, BF_plain{(const bf16*)(args.ws + WS_WOUT), D}, EF_resid{args.in[0], args.out}); }
    if (IN(4)) { p4_router(args, lds); }
    if (IN(5)) { p5_moe_up_naive(args, lds); }
    if (IN(6)) { p6_moe_down_naive(args, lds); }
    if (IN(7)) { p7_combine(args, lds); }
    if (IN(8)) { naive_gemm(lds, M / 64, D / 64, D, AF_plain{(const bf16*)(args.ws + WS_HN), D}, BF_plain{(const bf16*)(args.ws + WS_WPLG), D}, EF_ple{args.out, (const bf16*)(args.ws + WS_Y)}); }
    if (IN(9)) { p9_final(args); }
#undef IN
}

extern "C" void kernel_launch(void* const* d_in, const int* in_sizes, int n_in, void* d_out, int out_size, void* d_ws, size_t ws_size, hipStream_t stream) {
    static int grid = 0;
    if (grid == 0) {
        if (n_in != 22 || in_sizes[0] != M * D || out_size != M * D || ws_size < WS_END) {
            fprintf(stderr, "kernel_launch: unexpected shapes (n_in %d, in0 %d, out %d, ws %zu); nothing launched\n", n_in, n_in > 0 ? in_sizes[0] : -1, out_size, ws_size); grid = -1; return; }
        int dev = 0, cus = 0;
        if (hipGetDevice(&dev) != hipSuccess || hipDeviceGetAttribute(&cus, hipDeviceAttributeMultiprocessorCount, dev) != hipSuccess) { grid = -1; return; }
        if (hipFuncSetAttribute((const void*)fwd, hipFuncAttributeMaxDynamicSharedMemorySize, LDS_BYTES) != hipSuccess) { fprintf(stderr, "kernel_launch: hipFuncSetAttribute failed\n"); grid = -1; return; }
        int per_cu = 0;
        if (hipOccupancyMaxActiveBlocksPerMultiprocessor(&per_cu, (const void*)fwd, NTHR, LDS_BYTES) != hipSuccess || per_cu < 1) fprintf(stderr, "kernel_launch: occupancy query says %d\n", per_cu);
        (void)hipGetLastError();
        grid = cus;
    }
    if (grid < 0) return;
    hipMemsetAsync((char*)d_ws + WS_CTL, 0, CTL_ZERO_BYTES, stream);
    Args a{};
    for (int i = 0; i < 22; ++i) a.in[i] = (const float*)d_in[i];
    a.out = (float*)d_out; a.ws = (unsigned char*)d_ws;
    if (N_LAUNCHES == PER_PHASE) {
        for (int li = 0; li < PER_PHASE; ++li) { a.ph_lo = li; a.ph_hi = li + 1; hipLaunchKernelGGL(fwd, dim3(grid), dim3(NTHR), LDS_BYTES, stream, a); }
    } else {
        a.ph_lo = 0; a.ph_hi = PER_PHASE; hipLaunchKernelGGL(fwd, dim3(grid), dim3(NTHR), LDS_BYTES, stream, a);
    }
}
```

```cpp
#include <hip/hip_runtime.h>
#include <cstdio>
#include <cstdint>

#ifndef PROBE_DUP
#define PROBE_DUP (-1)
#endif
#ifndef PROBE_MX
#define PROBE_MX 0
#endif
#ifndef MK_N_LAUNCHES
#define MK_N_LAUNCHES 1
#endif

#define GAS __attribute__((address_space(1)))
#define LAS __attribute__((address_space(3)))
typedef unsigned short bf16;
typedef unsigned v4u __attribute__((ext_vector_type(4)));
typedef unsigned v2u __attribute__((ext_vector_type(2)));
typedef float f32x4 __attribute__((ext_vector_type(4)));
typedef float f32x2 __attribute__((ext_vector_type(2)));

constexpr int D = 1024, NBATCH = 16, T = 2048, M = NBATCH * T, PLE = 256;
constexpr int W = 512, NH = 4, HD = 128;
constexpr int INC = 4104, ZC = 4096;
constexpr int NE = 32, NG = 4, EPG = 8, DE = 512;
constexpr float EPS = 1e-6f;
constexpr int NWAVES = 8, NTHR = 512;
constexpr int PER_PHASE = 10;
constexpr int N_LAUNCHES = MK_N_LAUNCHES;

constexpr size_t MiB = 1u << 20;
constexpr size_t WS_CTL = 0, CTL_ZERO_BYTES = 1 * MiB;
constexpr size_t WS_WIN = 1 * MiB;
constexpr size_t WS_WOUT = 9 * MiB;
constexpr size_t WS_WPLG = 11 * MiB;
constexpr size_t WS_WPLP = 13 * MiB;
constexpr size_t WS_WGU = 14 * MiB;
constexpr size_t WS_WD = 78 * MiB;
constexpr size_t WS_LB = 110 * MiB;
constexpr size_t WS_GP = 111 * MiB;
constexpr size_t WS_TOKI = 112 * MiB;
constexpr size_t WS_TOKW = 112 * MiB + 640 * 1024;
constexpr size_t WS_HN = 113 * MiB;
constexpr size_t WS_Y = 177 * MiB;
constexpr size_t WS_Z = 241 * MiB;
constexpr size_t WS_HID = WS_Z;
constexpr size_t WS_YB = WS_Z + 76 * MiB;
constexpr size_t WS_LIST = WS_Z + 224 * MiB;
constexpr size_t WS_PB = WS_Z + 232 * MiB;
constexpr size_t WS_END = 497 * MiB;

constexpr int CW_CNT = 64;
constexpr int CW_BAR = 4096;

constexpr int LDS_BYTES = 163840;
constexpr int LDS_XB = LDS_BYTES - 16;

__device__ __forceinline__ float bf2f(bf16 b) { return __uint_as_float(((unsigned)b) << 16); }
__device__ __forceinline__ unsigned f2bf(float f) { unsigned u = __float_as_uint(f); return (u + 0x7fffu + ((u >> 16) & 1u)) >> 16; }
typedef __bf16 hw_bf16x2 __attribute__((ext_vector_type(2)));
__device__ __forceinline__ unsigned pk2(float lo, float hi) { f32x2 v = {lo, hi}; hw_bf16x2 b = __builtin_convertvector(v, hw_bf16x2); return __builtin_bit_cast(unsigned, b); }
__device__ __forceinline__ unsigned pk8(float a, float b, float c, float d) { int r = __builtin_amdgcn_cvt_pk_fp8_f32(a, b, 0, false); r = __builtin_amdgcn_cvt_pk_fp8_f32(c, d, r, true); return (unsigned)r; }
constexpr float F8_WSCALE = 32.f, F8_WINV = 1.f / 32.f;
__device__ __forceinline__ float wave_sum(float v) {
#pragma unroll
    for (int o = 1; o < 64; o <<= 1) v += __shfl_xor(v, o);
    return v;
}
__device__ __forceinline__ float fexp_(float x) { return __builtin_amdgcn_exp2f(x * 1.4426950408889634f); }
__device__ __forceinline__ float sigmoidf_(float x) { return __builtin_amdgcn_rcpf(1.0f + fexp_(-x)); }
__device__ __forceinline__ float siluf_(float x) { return x * __builtin_amdgcn_rcpf(1.0f + fexp_(-x)); }
__device__ __forceinline__ float logsigmoidf_(float x) { return fminf(x, 0.f) - log1pf(__expf(-fabsf(x))); }


#define XB_TMO      128
#define XB_XCNT(j)  (256  + 64 * (j))
#define XB_XSUB(j)  (1280 + 64 * (j))
#define XB_XGEN(j)  (2304 + 64 * (j))
#define XB_TOP      3328
#define XB_TOPGEN   3392
#define XCD_BAR_WORDS 3456
#define XB_SPIN_CAP (1u << 18)

__device__ __forceinline__ unsigned xb_ld(unsigned* p)              { return __hip_atomic_load(p, __ATOMIC_RELAXED, __HIP_MEMORY_SCOPE_AGENT); }
__device__ __forceinline__ unsigned xb_add(unsigned* p, unsigned v) { return __hip_atomic_fetch_add(p, v, __ATOMIC_RELAXED, __HIP_MEMORY_SCOPE_AGENT); }
__device__ __forceinline__ unsigned xb_xcc_id() { return (unsigned)__builtin_amdgcn_s_getreg((3 << 11) | 20) & 0xFu; }
#define XB_SPIN(cond, bar) do { unsigned _sp = 0; while (cond) { __builtin_amdgcn_s_sleep(1); \
    if ((++_sp & 255u) == 0u) { if (xb_ld(&(bar)[XB_TMO])) break; if (_sp > XB_SPIN_CAP) { atomicAdd(&(bar)[XB_TMO], 1u); break; } } } } while (0)

struct XcdBarrier {
    unsigned* bar; unsigned x;
    volatile LAS unsigned* st;
};
__device__ __forceinline__ XcdBarrier xcd_barrier_post(unsigned* bar, volatile LAS unsigned* st) {
    XcdBarrier b; b.bar = bar; b.x = xb_xcc_id(); b.st = st;
    if (threadIdx.x == 0) (void)xb_add(&bar[XB_XCNT(b.x)], 1u);
    return b;
}
__device__ __forceinline__ void xcd_barrier_complete(unsigned* bar, unsigned x, unsigned& nloc, unsigned& nx) {
    const unsigned G = gridDim.x * gridDim.y * gridDim.z;
    unsigned sum, cnt, mine, sp = 0u;
    for (;;) {
        sum = 0u; cnt = 0u; mine = 0u;
#pragma unroll
        for (unsigned j = 0; j < 16; ++j) { const unsigned c = xb_ld(&bar[XB_XCNT(j)]); sum += c; cnt += (c > 0u) ? 1u : 0u; mine = (j == x) ? c : mine; }
        if (sum == G) break;
        __builtin_amdgcn_s_sleep(1);
        if ((++sp & 255u) == 0u) { if (xb_ld(&bar[XB_TMO])) break; if (sp > XB_SPIN_CAP) { atomicAdd(&bar[XB_TMO], 1u); break; } }
    }
    nloc = mine > 0u ? mine : 1u; nx = cnt > 0u ? cnt : 1u;
}
__device__ __forceinline__ void xcd_barrier(const XcdBarrier& b) {
    asm volatile("s_waitcnt vmcnt(0)" ::: "memory");
    __syncthreads();
    if (threadIdx.x == 0) {
        unsigned* bar = b.bar;
        __builtin_amdgcn_s_waitcnt(0);
        unsigned nloc = b.st[0], nx = b.st[1];
        if (nloc == 0u) { xcd_barrier_complete(bar, b.x, nloc, nx); b.st[0] = nloc; b.st[1] = nx; }
        const unsigned old = xb_add(&bar[XB_XSUB(b.x)], 1u);
        const unsigned gen = old / nloc;
        if (old + 1u == (gen + 1u) * nloc) {
            __builtin_amdgcn_fence(__ATOMIC_RELEASE, "agent");
            asm volatile("s_waitcnt vmcnt(0)" ::: "memory");
            const unsigned og = xb_add(&bar[XB_TOP], 1u);
            const unsigned tg = og / nx;
            if (og + 1u == (tg + 1u) * nx) xb_add(&bar[XB_TOPGEN], 1u);
            else XB_SPIN(xb_ld(&bar[XB_TOPGEN]) == tg, bar);
            __builtin_amdgcn_fence(__ATOMIC_ACQUIRE, "agent");
            xb_add(&bar[XB_XGEN(b.x)], 1u);
            asm volatile("s_waitcnt vmcnt(0)" ::: "memory");
        } else {
            XB_SPIN(xb_ld(&bar[XB_XGEN(b.x)]) == gen, bar);
            __builtin_amdgcn_fence(__ATOMIC_ACQUIRE, "agent");
            asm volatile("s_waitcnt vmcnt(0)" ::: "memory");
        }
    }
    __syncthreads();
}

struct Args { const float* in[22]; float* out; unsigned char* ws; int ph_lo, ph_hi; };


namespace pg8 {
typedef unsigned short bf16_t;
typedef short bf16x8 __attribute__((ext_vector_type(8)));
typedef float f32x4 __attribute__((ext_vector_type(4)));
typedef unsigned u32x4 __attribute__((ext_vector_type(4)));
typedef int i32x4 __attribute__((ext_vector_type(4)));
constexpr int BM = 256, BK = 64, HALF = 128, HTB = HALF * BK * 2, STAGE_BYTES = 8 * HTB, NXCD = 8, WGM = 8;

__host__ __device__ __forceinline__ int lds_byte(int r, int c) { const int st = (r >> 4) * 2 + (c >> 5), rr = r & 15, cc = c & 31, ob = rr * 64 + cc * 2; return st * 1024 + (ob ^ (((ob >> 9) & 1) << 5)); }
__host__ __device__ __forceinline__ void stage_rc(int b, int& R, int& C) { const int st = b / 1024, sb = b % 1024, swz = sb ^ (((sb >> 9) & 1) << 5); R = (st >> 1) * 16 + swz / 64; C = (st & 1) * 32 + (swz % 64) / 2; }
__host__ __device__ __forceinline__ int perm32(int rho) { const int n = rho >> 4, i = rho & 15; return 8 * (i >> 2) + 4 * n + (i & 3); }

struct Unit { int pm, pn, ui; };
struct Gemm { const bf16_t* A; const bf16_t* Bt; int M, N, K, lda; };

struct StaticOrder {
    static constexpr bool HALF_UNITS = false;
    int nM, nN, nwg, G, c;
    __host__ __device__ void init(int M, int N, int G_, int c_) { nM = M / BM; nN = N / BM; nwg = nM * nN; G = G_; c = c_; }
    __host__ __device__ bool next(int i, Unit& u) const {
        const long L = (long)i * G + c; if (L >= nwg) return false;
        int wgid = (int)L; { const int q = nwg / NXCD, r = nwg % NXCD, xcd = wgid % NXCD, off = wgid / NXCD; wgid = (xcd < r ? xcd * (q + 1) : r * (q + 1) + (xcd - r) * q) + off; }
        const int nig = WGM * nN, gid = wgid / nig, fm = gid * WGM, gsz = (nM - fm) < WGM ? (nM - fm) : WGM;
        u.pm = fm + ((wgid % nig) % gsz); u.pn = (wgid % nig) / gsz; u.ui = i; return true;
    }
    __device__ __forceinline__ unsigned arow(const Unit&, int) const { return 0u; }
};

struct Col4Order {
    static constexpr bool HALF_UNITS = true;
    int nwg, G, c;
    __host__ __device__ void init(int M, int G_, int c_) { nwg = (M / BM) * 4; G = G_; c = c_; }
    __host__ __device__ bool next(int i, Unit& u) const {
        const int L = i * G + c; if (L >= nwg) return false;
        if (G == 256 && nwg == 512) { const int q = i * 32 + (c >> 3); u.pm = (c & 7) * 16 + (q >> 2); u.pn = q & 3; }
        else { u.pm = L >> 2; u.pn = L & 3; }
        u.ui = i; return true;
    }
    __device__ __forceinline__ unsigned arow(const Unit&, int) const { return 0u; }
};

__device__ __forceinline__ unsigned cvt_pk_bf16(float lo, float hi) { unsigned r; asm volatile("v_cvt_pk_bf16_f32 %0, %1, %2" : "=v"(r) : "v"(lo), "v"(hi)); return r; }

struct EpiStore {
    static constexpr bool PERM = true, PERM16 = false;
    bf16_t* O; int ldc; int pn_mask;
    __device__ __forceinline__ void operator()(const f32x4 (&acc)[2][2][4][2], const Unit& u, int wr, int wc, int fr, int fq) const {
        const int row0 = u.pm * BM + wr * 64 + fr; const int col0 = (u.pn & pn_mask) * BM + wc * 32 + 8 * fq;
#pragma unroll
        for (int ai = 0; ai < 2; ++ai)
#pragma unroll
            for (int m = 0; m < 4; ++m) { bf16_t* rowp = O + (size_t)(row0 + ai * HALF + m * 16) * ldc + col0;
#pragma unroll
                for (int bj = 0; bj < 2; ++bj) { const f32x4 v0 = acc[ai][bj][m][0], v1 = acc[ai][bj][m][1];
                    u32x4 w; w.x = cvt_pk_bf16(v0[0], v0[1]); w.y = cvt_pk_bf16(v0[2], v0[3]); w.z = cvt_pk_bf16(v1[0], v1[1]); w.w = cvt_pk_bf16(v1[2], v1[3]);
                    *(u32x4*)(rowp + bj * HALF) = w; } }
    }
};
struct EpiStore8 {
    static constexpr bool PERM = false, PERM16 = true;
    unsigned char* O; int ldc; int pn_mask;
    __device__ __forceinline__ void operator()(const f32x4 (&acc)[2][2][4][2], const Unit& u, int wr, int wc, int fr, int fq) const {
        const int row0 = u.pm * BM + wr * 64 + fr; const int col0 = (u.pn & pn_mask) * BM + wc * 64 + 16 * fq;
#pragma unroll
        for (int ai = 0; ai < 2; ++ai)
#pragma unroll
            for (int m = 0; m < 4; ++m) {
                u32x4 w;
                w.x = pk8(acc[ai][0][m][0][0], acc[ai][0][m][0][1], acc[ai][0][m][0][2], acc[ai][0][m][0][3]); w.y = pk8(acc[ai][0][m][1][0], acc[ai][0][m][1][1], acc[ai][0][m][1][2], acc[ai][0][m][1][3]);
                w.z = pk8(acc[ai][1][m][0][0], acc[ai][1][m][0][1], acc[ai][1][m][0][2], acc[ai][1][m][0][3]); w.w = pk8(acc[ai][1][m][1][0], acc[ai][1][m][1][1], acc[ai][1][m][1][2], acc[ai][1][m][1][3]);
                *(u32x4*)(O + (size_t)(row0 + ai * HALF + m * 16) * ldc + col0) = w; }
    }
};
struct EpiResid {
    static constexpr bool PERM = false, PERM16 = false;
    const float* __restrict__ X; float* __restrict__ O;
    __device__ __forceinline__ void operator()(const f32x4 (&acc)[2][2][4][2], const Unit& u, int wr, int wc, int fr, int fq) const {
        const int row0 = u.pm * BM + wr * 64 + fr; const int col0 = u.pn * BM + wc * 32 + 4 * fq;
#pragma unroll
        for (int ai = 0; ai < 2; ++ai)
#pragma unroll
            for (int mp = 0; mp < 2; ++mp) {
                f32x4 xv[2][2][2];
#pragma unroll
                for (int mm = 0; mm < 2; ++mm)
#pragma unroll
                    for (int bj = 0; bj < 2; ++bj)
#pragma unroll
                        for (int n = 0; n < 2; ++n) xv[mm][bj][n] = *(const f32x4*)(X + (size_t)(row0 + ai * HALF + (2 * mp + mm) * 16) * 1024 + col0 + bj * HALF + 16 * n);
#pragma unroll
                for (int mm = 0; mm < 2; ++mm)
#pragma unroll
                    for (int bj = 0; bj < 2; ++bj)
#pragma unroll
                        for (int n = 0; n < 2; ++n) *(f32x4*)(O + (size_t)(row0 + ai * HALF + (2 * mp + mm) * 16) * 1024 + col0 + bj * HALF + 16 * n) = xv[mm][bj][n] + acc[ai][bj][2 * mp + mm][n];
            }
    }
};
struct EpiSwiGLU {
    static constexpr bool PERM = true, PERM16 = false;
    unsigned char* O; const LAS int* tk; const float* rs;
    __device__ __forceinline__ void operator()(const f32x4 (&acc)[2][2][4][2], const Unit& u, int wr, int wc, int fr, int fq) const {
        const int row0 = u.pm * BM + wr * 64 + fr; const int col0 = (u.pn & 3) * HALF + wc * 32 + 8 * fq;
        float rsv[2][4];
#pragma unroll
        for (int ai = 0; ai < 2; ++ai)
#pragma unroll
            for (int m = 0; m < 4; ++m) rsv[ai][m] = rs[tk[(u.ui & 0xffff) * 256 + ai * HALF + wr * 64 + m * 16 + fr]] * F8_WINV;
#pragma unroll
        for (int ai = 0; ai < 2; ++ai)
#pragma unroll
            for (int m = 0; m < 4; ++m) { unsigned char* rowp = O + (size_t)(row0 + ai * HALF + m * 16) * 512 + col0;
                float h[8];
#pragma unroll
                for (int n = 0; n < 2; ++n)
#pragma unroll
                    for (int i = 0; i < 4; ++i) { const float gt = acc[ai][0][m][n][i] * rsv[ai][m], up = acc[ai][1][m][n][i] * rsv[ai][m]; h[4 * n + i] = gt * __builtin_amdgcn_rcpf(1.0f + __builtin_amdgcn_exp2f(gt * -1.4426950408889634f)) * up; }
                v2u w; w.x = pk8(h[0], h[1], h[2], h[3]); w.y = pk8(h[4], h[5], h[6], h[7]);
                *(v2u*)rowp = w; }
    }
};
struct EpiPle {
    static constexpr bool PERM = false, PERM16 = true;
    unsigned char* P; const float* rs;
    __device__ __forceinline__ void operator()(const f32x4 (&acc)[2][2][4][2], const Unit& u, int wr, int wc, int fr, int fq) const {
        const int row0 = u.pm * BM + wr * 64 + fr; const int col0 = u.pn * BM + wc * 64 + 16 * fq;
#pragma unroll
        for (int ai = 0; ai < 2; ++ai) {
            u32x4 pv[4]; float rsv[4];
#pragma unroll
            for (int m = 0; m < 4; ++m) rsv[m] = rs[row0 + ai * HALF + m * 16] * F8_WINV;
#pragma unroll
            for (int m = 0; m < 4; ++m) pv[m] = *(const u32x4*)(P + (size_t)(row0 + ai * HALF + m * 16) * 1024 + col0);
#pragma unroll
            for (int m = 0; m < 4; ++m) {
                u32x4 w;
#pragma unroll
                for (int d = 0; d < 4; ++d) {
                    const f32x4 a = acc[ai][d >> 1][m][d & 1] * rsv[m];
                    const f32x2 lo = __builtin_amdgcn_cvt_pk_f32_fp8((int)pv[m][d], false), hi = __builtin_amdgcn_cvt_pk_f32_fp8((int)pv[m][d], true);
#define PLE_SG(v) __builtin_amdgcn_rcpf(1.0f + __builtin_amdgcn_exp2f((v) * -1.4426950408889634f))
                    w[d] = pk8(lo.x * PLE_SG(a[0]), lo.y * PLE_SG(a[1]), hi.x * PLE_SG(a[2]), hi.y * PLE_SG(a[3]));
#undef PLE_SG
                }
                *(u32x4*)(P + (size_t)(row0 + ai * HALF + m * 16) * 1024 + col0) = w;
            }
        }
    }
};

template <class Epi, class Sched, bool GATHER = false, bool FP8 = false>
__device__ __forceinline__ void gemm_phase(LAS unsigned char* lds, const Gemm g, const Sched& S, const Epi& E) {
    int tid_l = threadIdx.x; asm volatile("" : "+v"(tid_l)); const int tid = tid_l, wid = __builtin_amdgcn_readfirstlane(tid >> 6), lane = tid & 63, wr = wid >> 2, wc = wid & 3, fr = lane & 15, fq = lane >> 4;
    const int K = g.K, nt = K / BK;
    unsigned voffA[2][2], voffAn[2][2], voffB[2];
#pragma unroll
    for (int i = 0; i < 2; ++i) { int R, C; stage_rc(tid * 16 + i * 8192, R, C);
        const int Rb = Epi::PERM16 ? (64 * (R >> 5) + 16 * ((R & 15) >> 2) + 4 * ((R >> 4) & 1) + (R & 3)) : Epi::PERM ? ((R & ~31) + perm32(R & 31)) : R;
        voffB[i] = (unsigned)(Rb * K + C) * 2u; }
    const size_t kstep = (size_t)(BK * 2);
    const size_t hstep = (size_t)HALF * K * 2;
    const size_t tstep = 2 * hstep;
    const size_t bstep = Epi::PERM16 ? (size_t)16 * K : hstep;
    const int lda = g.lda; const size_t tstepA = (size_t)BM * lda * 2;
    const unsigned ldsw = (unsigned)wid * 1024u;
    const int aoff = lds_byte(wr * 64 + fr, fq * 8), boff = lds_byte(wc * 32 + fr, fq * 8);
#define PG8_SA(b, h) (((b) * 2 + (h)) * HTB)
#define PG8_SB(b, h) ((4 + (b) * 2 + (h)) * HTB)
#define PG8_STAGE(bufoff, gbase, voff) do { _Pragma("unroll") for (int _i = 0; _i < 2; ++_i) \
        __builtin_amdgcn_global_load_lds((const unsigned*)((const char*)(gbase) + (voff)[_i]), (LAS unsigned*)(lds + (bufoff) + ldsw + _i * 8192), 16, 0, 0); } while (0)
#define PG8_LDA(dst, b, h) do { _Pragma("unroll") for (int m = 0; m < 4; ++m) _Pragma("unroll") for (int k = 0; k < 2; ++k) dst[m][k] = *(const LAS bf16x8*)(lds + PG8_SA(b, h) + aoff + m * 2048 + k * 1024); } while (0)
#define PG8_LDB(dst, b, h) do { _Pragma("unroll") for (int n = 0; n < 2; ++n) _Pragma("unroll") for (int k = 0; k < 2; ++k) dst[n][k] = *(const LAS bf16x8*)(lds + PG8_SB(b, h) + boff + n * 2048 + k * 1024); } while (0)
#define PG8_CAT(x, y) __builtin_shufflevector(__builtin_bit_cast(i32x4, x), __builtin_bit_cast(i32x4, y), 0, 1, 2, 3, 4, 5, 6, 7)
#define PG8_MMA(ai, bj, At, Bt) do { __builtin_amdgcn_s_setprio(1); _Pragma("unroll") for (int m = 0; m < 4; ++m) _Pragma("unroll") for (int n = 0; n < 2; ++n) { \
        if (FP8) acc[ai][bj][m][n] = __builtin_amdgcn_mfma_scale_f32_16x16x128_f8f6f4(PG8_CAT(Bt[n][0], Bt[n][1]), PG8_CAT(At[m][0], At[m][1]), acc[ai][bj][m][n], 0, 0, 0, 0, 0, 0); \
        else { _Pragma("unroll") for (int k = 0; k < 2; ++k) acc[ai][bj][m][n] = __builtin_amdgcn_mfma_f32_16x16x32_bf16(Bt[n][k], At[m][k], acc[ai][bj][m][n], 0, 0, 0); } } \
        __builtin_amdgcn_s_setprio(0); } while (0)
#define PG8_WAIT_V(n) asm volatile("s_waitcnt vmcnt(" #n ")" ::: "memory")
#define PG8_WAIT_L(n) asm volatile("s_waitcnt lgkmcnt(" #n ")" ::: "memory")
#define PG8_BAR __builtin_amdgcn_s_barrier()
#define PG8_SCHED __builtin_amdgcn_sched_barrier(0)
#define PG8_VOFF(dst, u) do { int _t = tid; asm volatile("" : "+v"(_t));   \
        _Pragma("unroll") for (int _i = 0; _i < 2; ++_i) { int _R, _C; stage_rc(_t * 16 + _i * 8192, _R, _C); _Pragma("unroll") for (int _h = 0; _h < 2; ++_h) \
        dst[_h][_i] = GATHER ? (unsigned)((S.arow(u, _h * HALF + _R) * (unsigned)lda + (unsigned)_C) * 2u) : (unsigned)(((_h * HALF + _R) * lda + _C) * 2); } } while (0)
    Unit cur, nxt; int ui = 0;
    if (!S.next(0, cur)) return;
    f32x4 acc[2][2][4][2];
#pragma unroll
    for (int a = 0; a < 2; ++a)
#pragma unroll
        for (int b = 0; b < 2; ++b)
#pragma unroll
            for (int m = 0; m < 4; ++m)
#pragma unroll
                for (int n = 0; n < 2; ++n) acc[a][b][m][n] = (f32x4){0.f, 0.f, 0.f, 0.f};
    bf16x8 At[4][2], B0[2][2], B1[2][2];
    PG8_VOFF(voffA, cur);
    const char* cA = (const char*)g.A + (GATHER ? (size_t)0 : (size_t)cur.pm * tstepA); const char* cB = (const char*)g.Bt + (size_t)cur.pn * tstep;
    PG8_STAGE(PG8_SB(0, 0), cB, voffB); PG8_STAGE(PG8_SB(0, 1), cB + bstep, voffB); PG8_STAGE(PG8_SA(0, 0), cA, voffA[0]); PG8_STAGE(PG8_SA(0, 1), cA, voffA[1]);
    if (wr == 1) PG8_BAR;
    PG8_WAIT_V(2); PG8_BAR;
    PG8_STAGE(PG8_SB(1, 0), cB + kstep, voffB); PG8_STAGE(PG8_SA(1, 0), cA + kstep, voffA[0]); PG8_STAGE(PG8_SB(1, 1), cB + bstep + kstep, voffB);
    PG8_WAIT_V(6); PG8_BAR;
    for (;;) {
        const bool has_next = S.next(ui + 1, nxt);
        const char* nA = has_next ? (const char*)g.A + (GATHER ? (size_t)0 : (size_t)nxt.pm * tstepA) : cA; const char* nB = has_next ? (const char*)g.Bt + (size_t)nxt.pn * tstep : cB;
        if (has_next) { PG8_VOFF(voffAn, nxt); }
        else {
#pragma unroll
            for (int _h = 0; _h < 2; ++_h)
#pragma unroll
                for (int _i = 0; _i < 2; ++_i) voffAn[_h][_i] = voffA[_h][_i]; }
        for (int t = 0; t < nt; t += 2) {
            const bool last = (t == nt - 2);
            const char* a1 = cA + (size_t)(t + 1) * kstep;
            const char* a2 = last ? nA : cA + (size_t)(t + 2) * kstep; const char* b2 = last ? nB : cB + (size_t)(t + 2) * kstep;
            const char* a3 = a2 + kstep; const char* b3 = b2 + kstep;
            unsigned vs0[2], vs1[2];
#pragma unroll
            for (int _i = 0; _i < 2; ++_i) { vs0[_i] = last ? voffAn[0][_i] : voffA[0][_i]; vs1[_i] = last ? voffAn[1][_i] : voffA[1][_i]; }
            PG8_LDB(B0, 0, 0); PG8_LDB(B1, 0, 1); PG8_SCHED; PG8_LDA(At, 0, 0); PG8_STAGE(PG8_SA(1, 1), a1, voffA[1]);
            PG8_WAIT_V(8); PG8_WAIT_L(0); PG8_BAR; PG8_MMA(0, 0, At, B0); PG8_MMA(0, 1, At, B1); PG8_BAR; PG8_SCHED;
            PG8_LDA(At, 0, 1); PG8_STAGE(PG8_SB(0, 0), b2, voffB); PG8_STAGE(PG8_SB(0, 1), b2 + bstep, voffB); PG8_STAGE(PG8_SA(0, 0), a2, vs0);
            PG8_WAIT_V(8); PG8_WAIT_L(0); PG8_BAR; if (!Sched::HALF_UNITS || !(cur.ui & 0x10000)) { PG8_MMA(1, 0, At, B0); PG8_MMA(1, 1, At, B1); } PG8_BAR; PG8_SCHED;
            PG8_LDB(B0, 1, 0); PG8_LDB(B1, 1, 1); PG8_SCHED; PG8_LDA(At, 1, 0); PG8_STAGE(PG8_SA(0, 1), a2, vs1);
            PG8_WAIT_V(8); PG8_WAIT_L(0); PG8_BAR; PG8_MMA(0, 0, At, B0); PG8_MMA(0, 1, At, B1); PG8_BAR; PG8_SCHED;
            PG8_LDA(At, 1, 1); PG8_STAGE(PG8_SB(1, 0), b3, voffB); PG8_STAGE(PG8_SB(1, 1), b3 + bstep, voffB); PG8_STAGE(PG8_SA(1, 0), a3, vs0);
            PG8_WAIT_V(8); PG8_WAIT_L(0); PG8_BAR; if (!Sched::HALF_UNITS || !(cur.ui & 0x10000)) { PG8_MMA(1, 0, At, B0); PG8_MMA(1, 1, At, B1); } PG8_BAR; PG8_SCHED;
        }
        if (wr == 0) PG8_BAR;
        E(acc, cur, wr, wc, fr, fq);
        if (!has_next) break;
#pragma unroll
        for (int a = 0; a < 2; ++a)
#pragma unroll
            for (int b = 0; b < 2; ++b)
#pragma unroll
                for (int m = 0; m < 4; ++m)
#pragma unroll
                    for (int n = 0; n < 2; ++n) acc[a][b][m][n] = (f32x4){0.f, 0.f, 0.f, 0.f};
        cur = nxt; cA = nA; cB = nB; ++ui;
#pragma unroll
        for (int _h = 0; _h < 2; ++_h)
#pragma unroll
            for (int _i = 0; _i < 2; ++_i) voffA[_h][_i] = voffAn[_h][_i];
        if (wr == 1) PG8_BAR;
    }
    PG8_WAIT_V(0);
    PG8_BAR;
#undef PG8_SA
#undef PG8_SB
#undef PG8_STAGE
#undef PG8_LDA
#undef PG8_LDB
#undef PG8_MMA
#undef PG8_CAT
#undef PG8_WAIT_V
#undef PG8_WAIT_L
#undef PG8_BAR
#undef PG8_SCHED
#undef PG8_VOFF
}
}

template <bool F8 = false>
__device__ __forceinline__ void tr_item(const float* src, int ld, int k0, int nsrc0, bf16* dst, int Kd, int ndst0, LAS float* scr, int lane, const float* ksc = nullptr) {
    const int kq = lane >> 3, n4 = (lane & 7) * 4;
#pragma unroll 1
    for (int hf = 0; hf < 2; ++hf) {
        f32x4 v[4];
#pragma unroll
        for (int i = 0; i < 4; ++i) { v[i] = *(const f32x4*)(src + (size_t)(k0 + kq + 8 * (4 * hf + i)) * ld + nsrc0 + n4); if (ksc) v[i] = v[i] * (ksc[k0 + kq + 8 * (4 * hf + i)] * (F8 ? F8_WSCALE : 1.f)); else if (F8) v[i] = v[i] * F8_WSCALE; }
#pragma unroll
        for (int i = 0; i < 4; ++i) { LAS float* s = scr + (kq + 8 * (4 * hf + i)) * 33 + n4; s[0] = v[i].x; s[1] = v[i].y; s[2] = v[i].z; s[3] = v[i].w; }
    }
    asm volatile("s_waitcnt lgkmcnt(0)" ::: "memory");
    const int c = lane & 7;
#pragma unroll
    for (int j = 0; j < 4; ++j) {
        const int n = (lane >> 3) + 8 * j; const LAS float* s = scr + (8 * c) * 33 + n;
        if (F8) { v2u o; o.x = pk8(s[0 * 33], s[1 * 33], s[2 * 33], s[3 * 33]); o.y = pk8(s[4 * 33], s[5 * 33], s[6 * 33], s[7 * 33]);
            *(v2u*)((unsigned char*)dst + (size_t)(ndst0 + n) * Kd + k0 + 8 * c) = o; }
        else { v4u o; o.x = pk2(s[0 * 33], s[1 * 33]); o.y = pk2(s[2 * 33], s[3 * 33]); o.z = pk2(s[4 * 33], s[5 * 33]); o.w = pk2(s[6 * 33], s[7 * 33]);
            *(v4u*)(dst + (size_t)(ndst0 + n) * Kd + k0 + 8 * c) = o; }
    }
    asm volatile("s_waitcnt lgkmcnt(0)" ::: "memory");
}

__device__ __forceinline__ void p0_prologue(const Args& a, LAS unsigned char* lds) {
    int tid_l = threadIdx.x; asm volatile("" : "+v"(tid_l)); const int tid = tid_l, lane = tid & 63, wave = tid >> 6, G = gridDim.x;
    unsigned char* ws = a.ws;
    LAS float* wg = (LAS float*)lds;
    LAS float* scr = (LAS float*)(lds + 32768 + wave * 8704);
    {
        const float* w_in = a.in[3];
        for (int i = tid; i < 8 * 1024; i += NTHR) { const int k = i >> 3, j = i & 7; wg[j * 1024 + k] = w_in[(size_t)k * INC + 2048 + j]; }
    }
    __syncthreads();
    const int gw = blockIdx.x * NWAVES + wave, NGW = G * NWAVES;
    constexpr int I_WIN = 16 * 128, I_SQ = 16 * 32, I_PLP = 4 * 32, I_GU = 16 * 32, I_D = 8 * 32;
    constexpr int NITEMS = I_WIN + 2 * I_SQ + I_PLP + NE * I_GU + NE * I_D;
    for (int it = gw; it < NITEMS; it += NGW) {
        int r = it;
        if (r < I_WIN) { const int kb = r / 128, nb = r % 128; const int nd = nb * 32; const int ns = nd < 2048 ? nd : nd + 8;
            tr_item(a.in[3], INC, kb * 64, ns, (bf16*)(ws + WS_WIN), D, nd, scr, lane); continue; }
        r -= I_WIN;
        if (r < I_SQ) { const int kb = r / 32, nb = r % 32; tr_item(a.in[9], D, kb * 64, nb * 32, (bf16*)(ws + WS_WOUT), D, nb * 32, scr, lane); continue; }
        r -= I_SQ;
        if (r < I_SQ) { const int kb = r / 32, nb = r % 32; tr_item<true>(a.in[19], D, kb * 64, nb * 32, (bf16*)(ws + WS_WPLG), D, nb * 32, scr, lane, a.in[18]); continue; }
        r -= I_SQ;
        if (r < I_PLP) { const int kb = r / 32, nb = r % 32; tr_item(a.in[20], D, kb * 64, nb * 32, (bf16*)(ws + WS_WPLP), PLE, nb * 32, scr, lane); continue; }
        r -= I_PLP;
        if (r < NE * I_GU) { const int e = r / I_GU, q = r % I_GU, kb = q / 32, nb = q % 32;
            const int nd = nb * 32, tile = nd >> 8, half = (nd >> 7) & 1, r0 = nd & 127;
            const float* src = (half ? a.in[16] : a.in[15]) + (size_t)e * D * DE;
            tr_item<true>(src, DE, kb * 64, tile * 128 + r0, (bf16*)(ws + WS_WGU + (size_t)e * 1024 * 1024), D, nd, scr, lane, a.in[10]); continue; }
        r -= NE * I_GU;
        { const int e = r / I_D, q = r % I_D, kb = q / 32, nb = q % 32;
            tr_item<true>(a.in[17] + (size_t)e * DE * D, D, kb * 64, nb * 32, (bf16*)(ws + WS_WD + (size_t)e * 1024 * 512), DE, nb * 32, scr, lane); }
    }
    if (blockIdx.x == 0) {
        const float* hl = a.in[7]; float* lb = (float*)(ws + WS_LB);
        for (int c = tid; c < W; c += NTHR) { const float a0 = hl[c], a1 = hl[W + c], mx = fmaxf(a0, a1); const float e0 = __expf(a0 - mx), e1 = __expf(a1 - mx); lb[c] = e0 / (e0 + e1); }
    }
    const float* x = a.in[0]; const float* g = a.in[2]; const float* bm = a.in[4];
    bf16* HN = (bf16*)(ws + WS_HN); float* GP = (float*)(ws + WS_GP);
    f32x4 gv[4];
#pragma unroll
    for (int j = 0; j < 4; ++j) gv[j] = *(const f32x4*)(g + 4 * lane + 256 * j);
    for (int m = gw * 2; m < M; m += NGW * 2) {
        f32x4 v[2][4]; float ss[2] = {0.f, 0.f};
#pragma unroll
        for (int r = 0; r < 2; ++r) { const f32x4* xr = (const f32x4*)(x + (size_t)(m + r) * D) + lane;
#pragma unroll
            for (int j = 0; j < 4; ++j) v[r][j] = xr[64 * j]; }
#pragma unroll
        for (int r = 0; r < 2; ++r)
#pragma unroll
            for (int j = 0; j < 4; ++j) ss[r] += (v[r][j].x * v[r][j].x + v[r][j].y * v[r][j].y) + (v[r][j].z * v[r][j].z + v[r][j].w * v[r][j].w);
#pragma unroll
        for (int r = 0; r < 2; ++r) {
            const float rstd = rsqrtf(wave_sum(ss[r]) * (1.f / D) + EPS);
#pragma unroll
            for (int j = 0; j < 4; ++j) v[r][j] = v[r][j] * rstd * gv[j];
            unsigned long long* o8 = (unsigned long long*)(HN + (size_t)(m + r) * D) + lane;
#pragma unroll
            for (int j = 0; j < 4; ++j) o8[64 * j] = (unsigned long long)pk2(v[r][j].x, v[r][j].y) | ((unsigned long long)pk2(v[r][j].z, v[r][j].w) << 32);
        }
        float gs[2][8];
#pragma unroll
        for (int q = 0; q < 8; ++q) {
            float s0 = 0.f, s1 = 0.f;
#pragma unroll
            for (int j = 0; j < 4; ++j) { const f32x4 wv = *(const LAS f32x4*)(wg + q * 1024 + 4 * lane + 256 * j);
                s0 += (v[0][j].x * wv.x + v[0][j].y * wv.y) + (v[0][j].z * wv.z + v[0][j].w * wv.w);
                s1 += (v[1][j].x * wv.x + v[1][j].y * wv.y) + (v[1][j].z * wv.z + v[1][j].w * wv.w); }
            gs[0][q] = wave_sum(s0); gs[1][q] = wave_sum(s1);
        }
        if (lane < 2) {
            const int r = lane;
            f32x4 o0 = {(r ? gs[1][0] : gs[0][0]) + bm[0], (r ? gs[1][1] : gs[0][1]) + bm[1], (r ? gs[1][2] : gs[0][2]) + bm[2], (r ? gs[1][3] : gs[0][3]) + bm[3]};
            f32x4 o1 = {(r ? gs[1][4] : gs[0][4]) + bm[4], (r ? gs[1][5] : gs[0][5]) + bm[5], (r ? gs[1][6] : gs[0][6]) + bm[6], (r ? gs[1][7] : gs[0][7]) + bm[7]};
            *(f32x4*)(GP + (size_t)(m + r) * 8) = o0; *(f32x4*)(GP + (size_t)(m + r) * 8 + 4) = o1;
        }
    }
}

typedef short mx_bf16x8 __attribute__((ext_vector_type(8)));
typedef __bf16 mx_bf16x2 __attribute__((ext_vector_type(2)));
__device__ __forceinline__ unsigned mx_cvt(float lo, float hi) { f32x2 v = {lo, hi}; mx_bf16x2 b = __builtin_convertvector(v, mx_bf16x2); return __builtin_bit_cast(unsigned, b); }
__device__ __forceinline__ mx_bf16x8 mx_frag(unsigned a, unsigned b, unsigned c, unsigned d) { v4u v = {a, b, c, d}; return __builtin_bit_cast(mx_bf16x8, v); }
__device__ __forceinline__ float seg16_cumsum(float v, int lane) {
#pragma unroll
    for (int o = 1; o < 16; o <<= 1) { const float u = __shfl_up(v, o); if ((lane & 15) >= o) v += u; }
    return v;
}
__device__ __forceinline__ float seg16_cummax(float v, int lane) {
#pragma unroll
    for (int o = 1; o < 16; o <<= 1) { const float u = __shfl_up(v, o); if ((lane & 15) >= o) v = fmaxf(v, u); }
    return v;
}
constexpr int MX_QB = 0, MX_KB = 17408, MX_KWT = 34816, MX_VT = 53248, MX_OB = 71680, MX_RAW = 105472, MX_GL = 140848, MX_NJ = 141360, MX_PS = 143408, MX_NC = 145456, MX_DEC = 145968, MX_CW = 148016, MX_GN = 152112, MX_TA = 152624, MX_TM = 152880, MX_TW = 153136, MX_TE = 153392, MX_TWD = 153648, MX_ZERO = 155696;
constexpr int MX_QP = 272, MX_TP = 144, MX_OP = 528, MX_RP = 528;
constexpr int MX_NBLK = T / 64;
#ifndef MX_SPLIT_M
#define MX_SPLIT_M 19
#endif
#ifndef MX_SPLIT_H
#define MX_SPLIT_H 19
#endif

#define MX_SYNC() do { asm volatile("s_waitcnt lgkmcnt(0)" ::: "memory"); __builtin_amdgcn_s_barrier(); asm volatile("" ::: "memory"); } while (0)
template <bool MLSTM>
__device__ __forceinline__ void mixer_unit(const Args& a, LAS unsigned char* lds, int b, int h, int seg) {
    int tid_l = threadIdx.x; asm volatile("" : "+v"(tid_l)); const int tid = tid_l, lane = tid & 63, w = __builtin_amdgcn_readfirstlane(tid >> 6), c = lane & 15, g = lane >> 4;
    const bf16* Z = (const bf16*)(a.ws + WS_Z); const float* GP = (const float*)(a.ws + WS_GP); bf16* Y = (bf16*)(a.ws + WS_Y);
    const float kscale = 0.08838834764831845f;
    constexpr int HALO = MLSTM ? 3 : 0, NRQ = 4;
    const int colA = (MLSTM ? 0 : 2048) + h * 128, colB = (MLSTM ? 512 : 2560) + h * 128, colV = (MLSTM ? 1024 : 3072) + h * 128, colO = (MLSTM ? 1536 : 3584) + h * 128;
    LAS float* GL = (LAS float*)(lds + MX_GL); LAS float* NJ = (LAS float*)(lds + MX_NJ); LAS float* PS = (LAS float*)(lds + MX_PS);
    LAS float* NC = (LAS float*)(lds + MX_NC); LAS float* DEC = (LAS float*)(lds + MX_DEC); LAS float* CW = (LAS float*)(lds + MX_CW);
    constexpr int MX_SPLIT = MLSTM ? MX_SPLIT_M : MX_SPLIT_H;
    const int blk_end = seg == 0 ? MX_SPLIT : MX_NBLK;
    MX_SYNC();
    if (MLSTM) {
        const float* convw = a.in[5];
        for (int i = tid; i < 4 * 256; i += NTHR) { const int j = i >> 8, ch = i & 255; CW[i] = convw[j * 1024 + (ch >> 7) * 512 + h * 128 + (ch & 127)]; }
        if (tid < 128) NC[tid] = 0.f;
        if (tid < 96) *(LAS v4u*)(lds + MX_RAW + (tid >> 5) * MX_RP + (tid & 31) * 16) = (v4u){0u, 0u, 0u, 0u};
    }
    f32x4 Ct[8];
#pragma unroll
    for (int i = 0; i < 8; ++i) Ct[i] = (f32x4){0.f, 0.f, 0.f, 0.f};
    float mu = -1.0e30f;
    const float lbv = MLSTM ? 0.f : ((const float*)(a.ws + WS_LB))[h * 128 + (tid & 127)];
    LAS float* GNL = (LAS float*)(lds + MX_GN);
    LAS float* TA = (LAS float*)(lds + MX_TA); LAS float* TM = (LAS float*)(lds + MX_TM); LAS float* TW = (LAS float*)(lds + MX_TW); LAS float* TE = (LAS float*)(lds + MX_TE);
    LAS float* TWD = (LAS float*)(lds + MX_TWD) + w * 64;
    if (tid < 16) ((LAS unsigned*)(lds + MX_ZERO))[tid] = 0u;
    if (tid < 128) GNL[tid] = MLSTM ? a.in[6][h * 128 + tid] : a.in[8][tid];
    v4u rq[NRQ], rv[2], ro[2]; float rg0 = 0.f, rg1 = 0.f;
#pragma unroll
    for (int i = 0; i < 2; ++i) ro[i] = (v4u){0u, 0u, 0u, 0u};
#define MX_PREFETCH(tb) do { \
        _Pragma("unroll") for (int _i = 0; _i < NRQ; ++_i) { const int piece = tid + NTHR * _i; const int rowi = piece >> 5, part = piece & 31; \
            rq[_i] = *(const v4u*)(Z + (size_t)(b * T + (tb) + rowi) * ZC + ((part >> 4) ? colB : colA) + (part & 15) * 8); } \
        _Pragma("unroll") for (int _i = 0; _i < 2; ++_i) { const int tp = lane & 31, eg = tid >> 5; \
            rv[_i] = *(const v4u*)(Z + (size_t)(b * T + (tb) + 2 * tp + _i) * ZC + colV + eg * 8); } \
        if (MLSTM && tid < 64) { const size_t row = (size_t)(b * T + (tb) + tid); rg0 = GP[row * 8 + h]; rg1 = GP[row * 8 + 4 + h]; } \
        asm volatile("" ::: "memory"); } while (0)
#define MX_CONSUME(vtoff) do { \
        _Pragma("unroll") for (int i = 0; i < NRQ; ++i) { const int piece = tid + NTHR * i; *(LAS v4u*)(lds + MX_RAW + (HALO + (piece >> 5)) * MX_RP + (piece & 31) * 16) = rq[i]; } \
        {     \
            const int tp = lane & 31, eg = tid >> 5; LAS unsigned* vt = (LAS unsigned*)(lds + (vtoff) + (eg * 8) * MX_TP + tp * 4); \
            const v4u x0 = rv[0], x1 = rv[1]; \
            vt[0 * (MX_TP / 4)] = (x0.x & 0xffffu) | (x1.x << 16); vt[1 * (MX_TP / 4)] = (x0.x >> 16) | (x1.x & 0xffff0000u); \
            vt[2 * (MX_TP / 4)] = (x0.y & 0xffffu) | (x1.y << 16); vt[3 * (MX_TP / 4)] = (x0.y >> 16) | (x1.y & 0xffff0000u); \
            vt[4 * (MX_TP / 4)] = (x0.z & 0xffffu) | (x1.z << 16); vt[5 * (MX_TP / 4)] = (x0.z >> 16) | (x1.z & 0xffff0000u); \
            vt[6 * (MX_TP / 4)] = (x0.w & 0xffffu) | (x1.w << 16); vt[7 * (MX_TP / 4)] = (x0.w >> 16) | (x1.w & 0xffff0000u); \
        } } while (0)
    int blk_begin = 0;
    if (seg == 1) {
        constexpr int NFF = MX_SPLIT * 64, NCH = (NFF + NTHR - 1) / NTHR;
        LAS float* WT = (LAS float*)(lds + MX_OB);
        LAS float* WS8 = (LAS float*)(lds + MX_PS);
        if (MLSTM) {
            float carry = 0.f, amax = -3.0e38f; float av[NCH];
#pragma unroll
            for (int k = 0; k < NCH; ++k) {
                const int s = tid + NTHR * k; float lfv = 0.f, igv = -3.0e38f;
                if (s < NFF) { const size_t row = (size_t)(b * T + s); igv = GP[row * 8 + h]; lfv = logsigmoidf_(GP[row * 8 + 4 + h]); }
                float inc = lfv;
#pragma unroll
                for (int o = 1; o < 64; o <<= 1) { const float u = __shfl_up(inc, o); if (lane >= o) inc += u; }
                if (lane == 63) WS8[w] = inc;
                MX_SYNC();
                float woff = 0.f, tot = 0.f;
#pragma unroll
                for (int q = 0; q < 8; ++q) { const float x = WS8[q]; tot += x; if (q < w) woff += x; }
                av[k] = igv - (carry + woff + inc);
                amax = fmaxf(amax, av[k]);
                carry += tot;
                MX_SYNC();
            }
#pragma unroll
            for (int o = 1; o < 64; o <<= 1) amax = fmaxf(amax, __shfl_xor(amax, o));
            if (lane == 0) WS8[8 + w] = amax;
            MX_SYNC();
            float m = 0.f;
#pragma unroll
            for (int q = 0; q < 8; ++q) m = fmaxf(m, WS8[8 + q]);
#pragma unroll
            for (int k = 0; k < NCH; ++k) { const int s = tid + NTHR * k; if (s < NFF) WT[s] = __expf(av[k] - m); }
            mu = carry + m;
        }
#define MX_FF_MMA(vtoff) do { _Pragma("unroll") for (int hk = 0; hk < 2; ++hk) {        \
            const v4u vf4 = *(const LAS v4u*)(lds + (vtoff) + (16 * w + c) * MX_TP + (32 * hk + 8 * g) * 2); \
            v4u kw4[8]; \
            _Pragma("unroll") for (int i = 0; i < 8; ++i) kw4[i] = *(const LAS v4u*)(lds + MX_KWT + (16 * i + c) * MX_TP + (32 * hk + 8 * g) * 2); \
            __builtin_amdgcn_sched_barrier(0); \
            _Pragma("unroll") for (int i = 0; i < 8; ++i) Ct[i] = __builtin_amdgcn_mfma_f32_16x16x32_bf16(__builtin_bit_cast(mx_bf16x8, kw4[i]), __builtin_bit_cast(mx_bf16x8, vf4), Ct[i], 0, 0, 0); } } while (0)
        constexpr int MX_VT2 = MX_OB + 8192;
        float nacc = 0.f, hcarry = 1.f;
        MX_PREFETCH(MLSTM ? 0 : (MX_SPLIT - 1) * 64);
#pragma unroll 1
        for (int j = 0; j < MX_SPLIT; ++j) {
            const int t0 = (MLSTM ? j : MX_SPLIT - 1 - j) * 64;
            MX_SYNC();
            MX_CONSUME((j & 1) ? MX_VT2 : MX_VT);
            if (j > 0) MX_FF_MMA(((j - 1) & 1) ? MX_VT2 : MX_VT);
            { const int tn = MLSTM ? t0 + 64 : (j + 1 < MX_SPLIT ? t0 - 64 : MX_SPLIT * 64); MX_PREFETCH(tn); }
            MX_SYNC();
            float kb[16]; float p = 1.f;
            if (MLSTM) {
#pragma unroll
                for (int it = 2; it < 4; ++it) {
                    const int item = tid + NTHR * it, rem = item & 1023, t = rem >> 4, dg = rem & 15;
                    float acc[8];
#pragma unroll
                    for (int i = 0; i < 8; ++i) acc[i] = 0.f;
#pragma unroll
                    for (int jt = 0; jt < 4; ++jt) {
                        const v4u zv = *(const LAS v4u*)(lds + MX_RAW + (t + jt) * MX_RP + 256 + dg * 16);
                        const LAS float* cw = CW + jt * 256 + 128 + dg * 8;
                        const f32x4 c0 = *(const LAS f32x4*)cw, c1 = *(const LAS f32x4*)(cw + 4);
                        acc[0] += c0.x * __uint_as_float(zv.x << 16); acc[1] += c0.y * __uint_as_float(zv.x & 0xffff0000u);
                        acc[2] += c0.z * __uint_as_float(zv.y << 16); acc[3] += c0.w * __uint_as_float(zv.y & 0xffff0000u);
                        acc[4] += c1.x * __uint_as_float(zv.z << 16); acc[5] += c1.y * __uint_as_float(zv.z & 0xffff0000u);
                        acc[6] += c1.z * __uint_as_float(zv.w << 16); acc[7] += c1.w * __uint_as_float(zv.w & 0xffff0000u);
                    }
#pragma unroll
                    for (int i = 0; i < 8; ++i) acc[i] = siluf_(acc[i]) * kscale;
                    v4u o; o.x = pk2(acc[0], acc[1]); o.y = pk2(acc[2], acc[3]); o.z = pk2(acc[4], acc[5]); o.w = pk2(acc[6], acc[7]);
                    *(LAS v4u*)(lds + MX_KB + t * MX_QP + dg * 16) = o;
                }
            } else {
                const int jj = tid >> 7, d = tid & 127;
#pragma unroll
                for (int i = 15; i >= 0; --i) {
                    const float fp = bf2f(((const LAS unsigned short*)(lds + MX_RAW + (16 * jj + i) * MX_RP + 256))[d]);
                    const float sg = sigmoidf_(fp);
                    kb[i] = (1.f - lbv) * (1.f - sg) * p;
                    p *= lbv + (1.f - lbv) * sg;
                }
                DEC[jj * 128 + d] = p;
            }
            MX_SYNC();
            if (MLSTM) {
                if (tid < 96) *(LAS v4u*)(lds + MX_RAW + (tid >> 5) * MX_RP + (tid & 31) * 16) = *(const LAS v4u*)(lds + MX_RAW + (64 + (tid >> 5)) * MX_RP + (tid & 31) * 16);
                const int jj = tid >> 7, d = tid & 127;
#pragma unroll 1
                for (int hf = 0; hf < 2; ++hf) { float kv8[8];
#pragma unroll
                    for (int i = 0; i < 8; ++i) { const int s = 16 * jj + 8 * hf + i; const float kv = bf2f(((const LAS unsigned short*)(lds + MX_KB + s * MX_QP))[d]) * WT[t0 + s]; kv8[i] = kv; nacc += kv; }
                    v4u o0; o0.x = pk2(kv8[0], kv8[1]); o0.y = pk2(kv8[2], kv8[3]); o0.z = pk2(kv8[4], kv8[5]); o0.w = pk2(kv8[6], kv8[7]);
                    *(LAS v4u*)(lds + MX_KWT + d * MX_TP + jj * 32 + 16 * hf) = o0; }
            } else {
                const int jj = tid >> 7, d = tid & 127;
                const float q0 = DEC[d], q1 = DEC[128 + d], q2 = DEC[256 + d], q3 = DEC[384 + d];
                const float sc = hcarry * (jj == 0 ? q1 * q2 * q3 : jj == 1 ? q2 * q3 : jj == 2 ? q3 : 1.f);
                hcarry *= (q0 * q1) * (q2 * q3);
#pragma unroll
                for (int i = 0; i < 16; ++i) kb[i] *= sc;
                v4u o0, o1;
                o0.x = pk2(kb[0], kb[1]); o0.y = pk2(kb[2], kb[3]); o0.z = pk2(kb[4], kb[5]); o0.w = pk2(kb[6], kb[7]);
                o1.x = pk2(kb[8], kb[9]); o1.y = pk2(kb[10], kb[11]); o1.z = pk2(kb[12], kb[13]); o1.w = pk2(kb[14], kb[15]);
                *(LAS v4u*)(lds + MX_KWT + d * MX_TP + jj * 32) = o0; *(LAS v4u*)(lds + MX_KWT + d * MX_TP + jj * 32 + 16) = o1;
            }
        }
        MX_SYNC();
        MX_FF_MMA(((MX_SPLIT - 1) & 1) ? MX_VT2 : MX_VT);
        if (MLSTM) {
            PS[tid] = nacc;
            MX_SYNC();
            if (tid < 128) NC[tid] = (PS[tid] + PS[128 + tid]) + (PS[256 + tid] + PS[384 + tid]);
        }
        blk_begin = MX_SPLIT;
    } else { MX_PREFETCH(0); }
    for (int blk = blk_begin; blk <= blk_end; ++blk) {
        const int t0 = blk * 64;
        const bool full = true, prev_full = blk > blk_begin;
        MX_SYNC();
        if (prev_full) for (int rep = 0; rep < ((PROBE_MX & 1) ? 2 : 1); ++rep) {
#pragma unroll
            for (int it = 0; it < 2; ++it) {
                const int t = w * 8 + 4 * it + g; const size_t row = (size_t)(b * T + t0 - 64 + t);
                const LAS float* ob = (const LAS float*)(lds + MX_OB + t * MX_OP) + c * 8;
                const f32x4 h0 = *(const LAS f32x4*)ob, h1 = *(const LAS f32x4*)(ob + 4);
                float hv[8] = {h0.x, h0.y, h0.z, h0.w, h1.x, h1.y, h1.z, h1.w};
                const v4u ov = ro[it];
                float og[8] = {__uint_as_float(ov.x << 16), __uint_as_float(ov.x & 0xffff0000u), __uint_as_float(ov.y << 16), __uint_as_float(ov.y & 0xffff0000u),
                               __uint_as_float(ov.z << 16), __uint_as_float(ov.z & 0xffff0000u), __uint_as_float(ov.w << 16), __uint_as_float(ov.w & 0xffff0000u)};
                float ss = 0.f;
#pragma unroll
                for (int i = 0; i < 8; ++i) { if (MLSTM) hv[i] *= sigmoidf_(og[i]); ss += hv[i] * hv[i]; }
                ss += __shfl_xor(ss, 1); ss += __shfl_xor(ss, 2); ss += __shfl_xor(ss, 4); ss += __shfl_xor(ss, 8);
                const float rs = rsqrtf(ss * (1.f / 128.f) + EPS);
                const f32x4 gn0 = *(const LAS f32x4*)(GNL + c * 8), gn1 = *(const LAS f32x4*)(GNL + c * 8 + 4);
                const float gnv[8] = {gn0.x, gn0.y, gn0.z, gn0.w, gn1.x, gn1.y, gn1.z, gn1.w};
#pragma unroll
                for (int i = 0; i < 8; ++i) { hv[i] = hv[i] * rs * gnv[i]; if (!MLSTM) hv[i] *= siluf_(og[i]); }
                v4u o; o.x = pk2(hv[0], hv[1]); o.y = pk2(hv[2], hv[3]); o.z = pk2(hv[4], hv[5]); o.w = pk2(hv[6], hv[7]);
                *(v4u*)(Y + row * D + (MLSTM ? 0 : W) + h * 128 + c * 8) = o;
            }
        }
        if (blk == blk_end) break;
        MX_CONSUME(MX_VT);
        if (MLSTM && tid < 64) { GL[tid] = rg0; GL[64 + tid] = logsigmoidf_(rg1); }
        if (full) {
#pragma unroll
            for (int i = 0; i < 2; ++i) { const int t = w * 8 + 4 * i + g; ro[i] = *(const v4u*)(Z + (size_t)(b * T + t0 + t) * ZC + colO + c * 8); }
        }
        if (blk + 1 < blk_end) { MX_PREFETCH(t0 + 64); }
        MX_SYNC();
#pragma unroll 1
        for (int rep = 0; rep < ((PROBE_MX & 2) ? 2 : 1); ++rep)
        if (MLSTM) {
#pragma unroll 1
            for (int it = (full ? 0 : 2); it < 4; ++it) {
                const int item = tid + NTHR * it, isk = item >> 10, rem = item & 1023, t = rem >> 4, dg = rem & 15;
                float acc[8];
#pragma unroll
                for (int i = 0; i < 8; ++i) acc[i] = 0.f;
#pragma unroll
                for (int j = 0; j < 4; ++j) {
                    const v4u zv = *(const LAS v4u*)(lds + MX_RAW + (t + j) * MX_RP + isk * 256 + dg * 16);
                    const LAS float* cw = CW + j * 256 + isk * 128 + dg * 8;
                    const f32x4 c0 = *(const LAS f32x4*)cw, c1 = *(const LAS f32x4*)(cw + 4);
                    acc[0] += c0.x * __uint_as_float(zv.x << 16); acc[1] += c0.y * __uint_as_float(zv.x & 0xffff0000u);
                    acc[2] += c0.z * __uint_as_float(zv.y << 16); acc[3] += c0.w * __uint_as_float(zv.y & 0xffff0000u);
                    acc[4] += c1.x * __uint_as_float(zv.z << 16); acc[5] += c1.y * __uint_as_float(zv.z & 0xffff0000u);
                    acc[6] += c1.z * __uint_as_float(zv.w << 16); acc[7] += c1.w * __uint_as_float(zv.w & 0xffff0000u);
                }
                const float sc = isk ? kscale : 1.0f;
#pragma unroll
                for (int i = 0; i < 8; ++i) acc[i] = siluf_(acc[i]) * sc;
                v4u o; o.x = pk2(acc[0], acc[1]); o.y = pk2(acc[2], acc[3]); o.z = pk2(acc[4], acc[5]); o.w = pk2(acc[6], acc[7]);
                *(LAS v4u*)(lds + (isk ? MX_KB : MX_QB) + t * MX_QP + dg * 16) = o;
            }
        } else {
            const int jj = tid >> 7, d = tid & 127;
            float kh[16]; float p = 1.f;
#pragma unroll
            for (int i = 0; i < 16; ++i) {
                const int t = 16 * jj + i;
                const float qp = bf2f(((const LAS unsigned short*)(lds + MX_RAW + t * MX_RP))[d]), fp = bf2f(((const LAS unsigned short*)(lds + MX_RAW + t * MX_RP + 256))[d]);
                const float sg = sigmoidf_(fp);
                const float f = lbv + (1.f - lbv) * sg, k = (1.f - lbv) * (1.f - sg);
                p *= f;
                const float khat = k * fminf(__builtin_amdgcn_rcpf(p), 1.0e26f);
                kh[i] = khat;
                if (full) {
                    ((LAS unsigned short*)(lds + MX_QB + t * MX_QP))[d] = (unsigned short)pk2(siluf_(qp) * p, 0.f);
                    ((LAS unsigned short*)(lds + MX_KB + t * MX_QP))[d] = (unsigned short)pk2(khat, 0.f);
                }
            }
            float kb[16];
#pragma unroll
            for (int i = 0; i < 16; ++i) kb[i] = kh[i] * p;
            const float G_unused = 0.f; (void)G_unused;
            v4u o0, o1;
            o0.x = pk2(kb[0], kb[1]); o0.y = pk2(kb[2], kb[3]); o0.z = pk2(kb[4], kb[5]); o0.w = pk2(kb[6], kb[7]);
            o1.x = pk2(kb[8], kb[9]); o1.y = pk2(kb[10], kb[11]); o1.z = pk2(kb[12], kb[13]); o1.w = pk2(kb[14], kb[15]);
            *(LAS v4u*)(lds + MX_KWT + d * MX_TP + jj * 32) = o0; *(LAS v4u*)(lds + MX_KWT + d * MX_TP + jj * 32 + 16) = o1;
            DEC[jj * 128 + d] = p;
        }
        MX_SYNC();
        if (MLSTM && tid < 96) *(LAS v4u*)(lds + MX_RAW + (tid >> 5) * MX_RP + (tid & 31) * 16) = *(const LAS v4u*)(lds + MX_RAW + (64 + (tid >> 5)) * MX_RP + (tid & 31) * 16);
        float sc_a = 0.f, sc_M = 0.f, sc_wi = 0.f, sc_em = 0.f, sc_wd = 0.f; float alpha[4] = {1.f, 1.f, 1.f, 1.f};
        if (MLSTM) {
            const float ig = GL[lane], lf = GL[64 + lane];
            const float bc = seg16_cumsum(lf, lane); const float av = ig - bc; const float Ml = seg16_cummax(av, lane);
            float mus[5]; mus[0] = mu; float bl[4];
#pragma unroll
            for (int jj = 0; jj < 4; ++jj) { bl[jj] = __shfl(bc, 16 * jj + 15); const float am = __shfl(Ml, 16 * jj + 15);
                mus[jj + 1] = fmaxf(bl[jj] + mus[jj], bl[jj] + am); alpha[jj] = __expf(bl[jj] + mus[jj] - mus[jj + 1]); }
            mu = mus[4];
            const int lj = lane >> 4;
            const float my_mu = lj == 0 ? mus[0] : lj == 1 ? mus[1] : lj == 2 ? mus[2] : mus[3];
            const float my_mun = lj == 0 ? mus[1] : lj == 1 ? mus[2] : lj == 2 ? mus[3] : mus[4];
            const float my_bl = lj == 0 ? bl[0] : lj == 1 ? bl[1] : lj == 2 ? bl[2] : bl[3];
            sc_a = av; sc_M = fmaxf(my_mu, Ml); sc_wi = __expf(my_mu - sc_M); sc_em = __expf(-(bc + sc_M));
            if (w == 0) { TA[lane] = sc_a; TM[lane] = sc_M; TW[lane] = sc_wi; TE[lane] = sc_em; }
            const float kwt = __expf(my_bl + av - my_mun);
            for (int rep = 0; rep < ((PROBE_MX & 4) ? 2 : 1); ++rep) {
                const int jj = tid >> 7, d = tid & 127; float ps = 0.f;
#pragma unroll 1
                for (int hf = 0; hf < 2; ++hf) { float kb[8];
#pragma unroll
                    for (int i = 0; i < 8; ++i) { const int s = 16 * jj + 8 * hf + i; const float kv = bf2f(((const LAS unsigned short*)(lds + MX_KB + s * MX_QP))[d]) * __shfl(kwt, s); kb[i] = kv; ps += kv; }
                    v4u o0; o0.x = pk2(kb[0], kb[1]); o0.y = pk2(kb[2], kb[3]); o0.z = pk2(kb[4], kb[5]); o0.w = pk2(kb[6], kb[7]);
                    *(LAS v4u*)(lds + MX_KWT + d * MX_TP + jj * 32 + 16 * hf) = o0; }
                PS[jj * 128 + d] = ps;
            }
            MX_SYNC();
            if (tid < 128) { float n = NC[tid];
#pragma unroll
                for (int jj = 0; jj < 4; ++jj) { NJ[jj * 128 + tid] = n; n = alpha[jj] * n + PS[jj * 128 + tid]; }
                NC[tid] = n; }
            MX_SYNC();
        }
        LAS unsigned char* PAB = lds + MX_PS;
        LAS float* DN1 = (LAS float*)(lds + MX_TWD); LAS float* DN2 = DN1 + 64;
        if (full) {
            const int js = w & 3, T0p = 16 * js;
            mx_bf16x8 qfp[4];
#pragma unroll
            for (int kk = 0; kk < 4; ++kk) { const LAS unsigned char* qp = lds + MX_QB + (T0p + c) * MX_QP + (32 * kk + 4 * g) * 2; const v2u ql = *(const LAS v2u*)qp, qh = *(const LAS v2u*)(qp + 32); qfp[kk] = mx_frag(ql.x, ql.y, qh.x, qh.y); }
            if (w < 4) {
                mx_bf16x8 kf[4];
#pragma unroll
                for (int kk = 0; kk < 4; ++kk) { const LAS unsigned char* kp = lds + MX_KB + (T0p + c) * MX_QP + (32 * kk + 4 * g) * 2; const v2u kl = *(const LAS v2u*)kp, kh = *(const LAS v2u*)(kp + 32); kf[kk] = mx_frag(kl.x, kl.y, kh.x, kh.y); }
                __builtin_amdgcn_sched_barrier(0);
                f32x4 ST = {0.f, 0.f, 0.f, 0.f};
#pragma unroll
                for (int kk = 0; kk < 4; ++kk) ST = __builtin_amdgcn_mfma_f32_16x16x32_bf16(kf[kk], qfp[kk], ST, 0, 0, 0);
                float P[4];
                if (MLSTM) {
                    const float Mt = TM[T0p + c]; const f32x4 as4 = *(const LAS f32x4*)(TA + T0p + 4 * g);
#pragma unroll
                    for (int r = 0; r < 4; ++r) { const float ee = __expf(as4[r] - Mt); P[r] = (4 * g + r <= c) ? ST[r] * ee : 0.f; }
                    float dint = (P[0] + P[1]) + (P[2] + P[3]); dint += __shfl_xor(dint, 16); dint += __shfl_xor(dint, 32);
                    if (g == 0) DN1[T0p + c] = dint;
                } else {
#pragma unroll
                    for (int r = 0; r < 4; ++r) P[r] = (4 * g + r <= c) ? ST[r] : 0.f;
                }
                v2u pa2; pa2.x = mx_cvt(P[0], P[1]); pa2.y = mx_cvt(P[2], P[3]);
                *(LAS v2u*)(PAB + (js * 64 + lane) * 8) = pa2;
            } else if (MLSTM) {
                f32x4 n0[4], n1[4];
#pragma unroll
                for (int kk = 0; kk < 4; ++kk) { n0[kk] = *(const LAS f32x4*)(NJ + js * 128 + 32 * kk + 4 * g); n1[kk] = *(const LAS f32x4*)(NJ + js * 128 + 32 * kk + 16 + 4 * g); }
                __builtin_amdgcn_sched_barrier(0);
                f32x4 DI = {0.f, 0.f, 0.f, 0.f};
#pragma unroll
                for (int kk = 0; kk < 4; ++kk) DI = __builtin_amdgcn_mfma_f32_16x16x32_bf16(qfp[kk], mx_frag(mx_cvt(n0[kk].x, n0[kk].y), mx_cvt(n0[kk].z, n0[kk].w), mx_cvt(n1[kk].x, n1[kk].y), mx_cvt(n1[kk].z, n1[kk].w)), DI, 0, 0, 0);
                if (c == 0) *(LAS f32x4*)(DN2 + T0p + 4 * g) = DI;
            }
        }
        MX_SYNC();
#pragma unroll 1
        for (int jj = 0; jj < 4; ++jj) {
            const int T0 = 16 * jj;
            const float alpha_j = jj == 0 ? alpha[0] : jj == 1 ? alpha[1] : jj == 2 ? alpha[2] : alpha[3];
            if (full)
#pragma unroll 1
            for (int rep = 0; rep < ((PROBE_MX & 16) ? 2 : 1); ++rep) {
                mx_bf16x8 qf[4];
#pragma unroll
                for (int kk = 0; kk < 4; ++kk) { const LAS unsigned char* qp = lds + MX_QB + (T0 + c) * MX_QP + (32 * kk + 4 * g) * 2; const v2u ql = *(const LAS v2u*)qp, qh = *(const LAS v2u*)(qp + 32); qf[kk] = mx_frag(ql.x, ql.y, qh.x, qh.y); }
                const v2u pa2 = *(const LAS v2u*)(PAB + (jj * 64 + lane) * 8);
                const mx_bf16x8 pa = mx_frag(pa2.x, pa2.y, 0u, 0u);
                const v2u vl = *(const LAS v2u*)(lds + MX_VT + (16 * w + c) * MX_TP + (T0 + 4 * g) * 2);
                const mx_bf16x8 vb = mx_frag(vl.x, vl.y, 0u, 0u);
                __builtin_amdgcn_sched_barrier(0);
                f32x4 OC = {0.f, 0.f, 0.f, 0.f};
#pragma unroll
                for (int kk = 0; kk < 4; ++kk) {
                    const mx_bf16x8 cf = mx_frag(mx_cvt(Ct[2 * kk][0], Ct[2 * kk][1]), mx_cvt(Ct[2 * kk][2], Ct[2 * kk][3]), mx_cvt(Ct[2 * kk + 1][0], Ct[2 * kk + 1][1]), mx_cvt(Ct[2 * kk + 1][2], Ct[2 * kk + 1][3]));
                    OC = __builtin_amdgcn_mfma_f32_16x16x32_bf16(qf[kk], cf, OC, 0, 0, 0);
                }
                if (MLSTM) {
                    OC = OC * *(const LAS f32x4*)(TW + T0 + 4 * g);
                }
                OC = __builtin_amdgcn_mfma_f32_16x16x32_bf16(pa, vb, OC, 0, 0, 0);
                LAS float* ob = (LAS float*)(lds + MX_OB + (T0 + 4 * g) * MX_OP) + 16 * w + c;
                if (MLSTM) {
                    const f32x4 wi4b = *(const LAS f32x4*)(TW + T0 + 4 * g), em4 = *(const LAS f32x4*)(TE + T0 + 4 * g);
                    const f32x4 den4 = *(const LAS f32x4*)(DN1 + T0 + 4 * g) + wi4b * *(const LAS f32x4*)(DN2 + T0 + 4 * g);
#pragma unroll
                    for (int r = 0; r < 4; ++r) ob[r * (MX_OP / 4)] = OC[r] * __builtin_amdgcn_rcpf(fmaxf(fabsf(den4[r]), em4[r]));
                } else {
#pragma unroll
                    for (int r = 0; r < 4; ++r) ob[r * (MX_OP / 4)] = OC[r];
                }
            }
            const int vaddr = g < 2 ? MX_VT + (16 * w + c) * MX_TP + (T0 + 8 * g) * 2 : MX_ZERO;
            const int kaddr = g < 2 ? MX_KWT + c * MX_TP + (T0 + 8 * g) * 2 : MX_ZERO, kstr = g < 2 ? 16 * MX_TP : 0;
            const v4u vf4 = *(const LAS v4u*)(lds + vaddr);
            const mx_bf16x8 vf = __builtin_bit_cast(mx_bf16x8, vf4);
#pragma unroll
            for (int ih = 0; ih < 2; ++ih) {
                v4u kw4[4]; f32x4 dc[4];
#pragma unroll
                for (int i = 0; i < 4; ++i) { kw4[i] = *(const LAS v4u*)(lds + kaddr + (4 * ih + i) * kstr); if (!MLSTM) dc[i] = *(const LAS f32x4*)(DEC + jj * 128 + 16 * (4 * ih + i) + 4 * g); }
                __builtin_amdgcn_sched_barrier(0);
#pragma unroll
                for (int i = 0; i < 4; ++i) {
                    if (MLSTM) Ct[4 * ih + i] = Ct[4 * ih + i] * alpha_j; else Ct[4 * ih + i] = Ct[4 * ih + i] * dc[i];
                    Ct[4 * ih + i] = __builtin_amdgcn_mfma_f32_16x16x32_bf16(__builtin_bit_cast(mx_bf16x8, kw4[i]), vf, Ct[4 * ih + i], 0, 0, 0);
                }
            }
        }
    }
#undef MX_PREFETCH
#undef MX_CONSUME
#undef MX_FF_MMA
}

__device__ __forceinline__ void p2_mixers_fast(const Args& a, LAS unsigned char* lds) {
    for (int u = blockIdx.x; u < 256; u += gridDim.x) {
        const int seg = u & 1, mix = (u >> 1) & 1, bh = u >> 2;
        if (mix == 0) mixer_unit<true>(a, lds, bh >> 2, bh & 3, seg);
        else mixer_unit<false>(a, lds, bh >> 2, bh & 3, seg);
    }
}

__device__ __forceinline__ void p4_router(const Args& a, LAS unsigned char* lds) {
    int tid_l = threadIdx.x; asm volatile("" : "+v"(tid_l)); const int tid = tid_l, lane = tid & 63, wave = tid >> 6, G = gridDim.x;
    unsigned char* ws = a.ws;
    constexpr int WRP = 1028;
    LAS float* wr = (LAS float*)lds;
    LAS int* hist = (LAS int*)(lds + 36 * WRP * 4);
    LAS int* base = hist + 32;
    LAS int* rowE = base + 32;
    LAS int* rowP = rowE + 256;
    {
        const float* w_rg = a.in[11]; const float* w_re = a.in[13];
        for (int i = tid; i < 4 * 1024; i += NTHR) { const int k = i >> 2, j = i & 3; wr[j * WRP + k] = w_rg[i]; }
        for (int i = tid; i < 32 * 1024; i += NTHR) { const int k = i >> 5, j = i & 31; wr[(4 + j) * WRP + k] = w_re[i]; }
        if (tid < 32) hist[tid] = 0;
    }
    __syncthreads();
    const float* x1 = a.out; const float* xin = a.in[0]; const float* g = a.in[10]; const float* b_rg = a.in[12]; const float* b_re = a.in[14];
    bf16* HN = (bf16*)(ws + WS_HN);
    int* cnt = (int*)(ws + WS_CTL) + CW_CNT; int* list = (int*)(ws + WS_LIST);
    int4* toki = (int4*)(ws + WS_TOKI); float2* tokw = (float2*)(ws + WS_TOKW);
    f32x4 gv[4];
#pragma unroll
    for (int j = 0; j < 4; ++j) gv[j] = *(const f32x4*)(g + 4 * lane + 256 * j);
    for (int rb = blockIdx.x; rb < M / 128; rb += G) {
#pragma unroll 1
        for (int rr = 0; rr < 8; ++rr) {
            const int lr0 = wave * 16 + 2 * rr, m0 = rb * 128 + lr0;
            f32x4 v[2][4]; float ss[2] = {0.f, 0.f};
            v2u mxv[2][4];
#pragma unroll
            for (int r = 0; r < 2; ++r) { const f32x4* xr = (const f32x4*)(xin + (size_t)(m0 + r) * D) + lane; const v2u* mr = (const v2u*)((const bf16*)x1 + (size_t)(m0 + r) * 2048 + 1024) + lane;
#pragma unroll
                for (int j = 0; j < 4; ++j) { v[r][j] = xr[64 * j]; mxv[r][j] = mr[64 * j]; } }
#pragma unroll
            for (int r = 0; r < 2; ++r)
#pragma unroll
                for (int j = 0; j < 4; ++j) { v[r][j].x += __uint_as_float(mxv[r][j].x << 16); v[r][j].y += __uint_as_float(mxv[r][j].x & 0xffff0000u); v[r][j].z += __uint_as_float(mxv[r][j].y << 16); v[r][j].w += __uint_as_float(mxv[r][j].y & 0xffff0000u);
                    ((unsigned long long*)((bf16*)a.out + (size_t)(m0 + r) * 2048) + lane)[64 * j] = (unsigned long long)pk2(v[r][j].x, v[r][j].y) | ((unsigned long long)pk2(v[r][j].z, v[r][j].w) << 32);
                    ((unsigned*)(ws + WS_HN) + (size_t)(m0 + r) * 256 + lane)[64 * j] = pk8(v[r][j].x, v[r][j].y, v[r][j].z, v[r][j].w); }
#pragma unroll
            for (int r = 0; r < 2; ++r)
#pragma unroll
                for (int j = 0; j < 4; ++j) ss[r] += (v[r][j].x * v[r][j].x + v[r][j].y * v[r][j].y) + (v[r][j].z * v[r][j].z + v[r][j].w * v[r][j].w);
#pragma unroll
            for (int r = 0; r < 2; ++r) {
                const float rstd = rsqrtf(wave_sum(ss[r]) * (1.f / D) + EPS);
                if (lane == 0) ((float*)(ws + WS_GP))[m0 + r] = rstd;
#pragma unroll
                for (int j = 0; j < 4; ++j) v[r][j] = v[r][j] * rstd * gv[j];
            }
            float gl[2][4];
#pragma unroll
            for (int q = 0; q < 4; ++q) { float s0 = 0.f, s1 = 0.f;
#pragma unroll
                for (int j = 0; j < 4; ++j) { const f32x4 wv = *(const LAS f32x4*)(wr + q * WRP + 4 * lane + 256 * j);
                    s0 += (v[0][j].x * wv.x + v[0][j].y * wv.y) + (v[0][j].z * wv.z + v[0][j].w * wv.w);
                    s1 += (v[1][j].x * wv.x + v[1][j].y * wv.y) + (v[1][j].z * wv.z + v[1][j].w * wv.w); }
                gl[0][q] = wave_sum(s0) + b_rg[q]; gl[1][q] = wave_sum(s1) + b_rg[q]; }
#pragma unroll
            for (int r = 0; r < 2; ++r) {
                int gsel = 0; float gmax = gl[r][0];
#pragma unroll
                for (int q = 1; q < 4; ++q) if (gl[r][q] > gmax) { gmax = gl[r][q]; gsel = q; }
                float gsum = 0.f;
#pragma unroll
                for (int q = 0; q < 4; ++q) gsum += __expf(gl[r][q] - gmax);
                const float gval = 1.f / gsum;
                float el[8];
#pragma unroll
                for (int q = 0; q < 8; ++q) { float s = 0.f; const LAS float* wrow = wr + (4 + gsel * 8 + q) * WRP;
#pragma unroll
                    for (int j = 0; j < 4; ++j) { const f32x4 wv = *(const LAS f32x4*)(wrow + 4 * lane + 256 * j); s += (v[r][j].x * wv.x + v[r][j].y * wv.y) + (v[r][j].z * wv.z + v[r][j].w * wv.w); }
                    el[q] = wave_sum(s) + b_re[gsel * 8 + q]; }
                int i0 = 0; float v0 = el[0];
#pragma unroll
                for (int q = 1; q < 8; ++q) if (el[q] > v0) { v0 = el[q]; i0 = q; }
                int i1 = -1; float v1 = -3.0e38f;
#pragma unroll
                for (int q = 0; q < 8; ++q) if (q != i0 && el[q] > v1) { v1 = el[q]; i1 = q; }
                if (lane == 0) {
                    const int lr = lr0 + r;
                    const float p1 = 1.f / (1.f + __expf(v0 - v1));
                    const float p0 = 1.f - p1;
                    const int e0 = gsel * 8 + i0, e1 = gsel * 8 + i1;
                    rowE[lr * 2] = e0; rowE[lr * 2 + 1] = e1;
                    rowP[lr * 2] = __hip_atomic_fetch_add(&hist[e0], 1, __ATOMIC_RELAXED, __HIP_MEMORY_SCOPE_WORKGROUP); rowP[lr * 2 + 1] = __hip_atomic_fetch_add(&hist[e1], 1, __ATOMIC_RELAXED, __HIP_MEMORY_SCOPE_WORKGROUP);
                    tokw[m0 + r] = make_float2(p0 * gval, p1 * gval);
                }
            }
        }
        __syncthreads();
        if (tid < 32) { const int c = hist[tid]; base[tid] = c ? atomicAdd(&cnt[tid], c) : 0; }
        __syncthreads();
        if (tid < 128) {
            const int m = rb * 128 + tid, e0 = rowE[tid * 2], e1 = rowE[tid * 2 + 1];
            const int q0 = base[e0] + rowP[tid * 2], q1 = base[e1] + rowP[tid * 2 + 1];
            toki[m] = make_int4(e0, e1, q0, q1);
            list[e0 * M + q0] = m; list[e1 * M + q1] = m;
        }
        __syncthreads();
        if (tid < 32) hist[tid] = 0;
        __syncthreads();
    }
    {
        const f32x4* p4 = (const f32x4*)a.in[1]; v2u* pb = (v2u*)(ws + WS_PB);
        const size_t n4 = (size_t)M * PLE / 4;
        for (size_t i = (size_t)blockIdx.x * NTHR + tid; i < n4; i += (size_t)G * NTHR) { const f32x4 v = p4[i]; v2u o; o.x = pk2(v.x, v.y); o.y = pk2(v.z, v.w); pb[i] = o; }
    }
}

__device__ __forceinline__ void load_pstart(const Args& a, LAS int* ps, LAS int* cn) {
    if (threadIdx.x < 64) {
        const int lane = threadIdx.x; const int* cnt = (const int*)(a.ws + WS_CTL) + CW_CNT;
        const int c = lane < NE ? __hip_atomic_load(cnt + lane, __ATOMIC_RELAXED, __HIP_MEMORY_SCOPE_AGENT) : 0;
        const int pad = (c + 255) & ~255; int inc = pad;
#pragma unroll
        for (int o = 1; o < 64; o <<= 1) { const int u = __shfl_up(inc, o); if (lane >= o) inc += u; }
        if (lane < NE) { cn[lane] = c; ps[lane] = inc - pad; }
        if (lane == NE - 1) ps[NE] = inc;
    }
    __syncthreads();
}


struct MoeOrder {
    static constexpr bool HALF_UNITS = true;
    const LAS int* ps; const LAS int* cn; const int* list; int G, c, nunits; const LAS int* tk;
    __device__ __forceinline__ bool next(int i, pg8::Unit& u) const {
        const int L = i * G + c; if (L >= nunits) return false;
        const int rt = L >> 2, ct = L & 3, row0 = rt * 256; int e = 0;
        for (int q = 1; q < NE; ++q) if (ps[q] <= row0) e = q;
        u.pm = rt; u.pn = e * 4 + ct; u.ui = i | (((cn[e] - (row0 - ps[e])) <= 128) ? 0x10000 : 0); return true;
    }
    __device__ __forceinline__ unsigned arow(const pg8::Unit& u, int r) const { const int o = u.ui & 0xffff; return o < 24 ? (unsigned)tk[o * 256 + r] : (unsigned)tok(u, r); }
    __device__ __forceinline__ int tok(const pg8::Unit& u, int r) const { const int e = u.pn >> 2, pos = u.pm * 256 - ps[e] + r; return pos < cn[e] ? list[e * M + pos] : 0; }
};
__device__ __forceinline__ void p5_moe_up(const Args& a, LAS unsigned char* lds) {
    LAS int* ps = (LAS int*)(lds + 131072); LAS int* cn = ps + 40;
    load_pstart(a, ps, cn);
    LAS int* tk = (LAS int*)(lds + 131072 + 1024);
    MoeOrder S{ps, cn, (const int*)(a.ws + WS_LIST), (int)gridDim.x, (int)blockIdx.x, (ps[NE] / 256) * 4, tk};
    {   pg8::Unit u;
        for (int i = 0; i < 24 && S.next(i, u); ++i) if (threadIdx.x < 256) tk[i * 256 + threadIdx.x] = S.tok(u, threadIdx.x);
        __syncthreads(); }
    pg8::Gemm g{(const bf16*)(a.ws + WS_HN), (const bf16*)(a.ws + WS_WGU), 0, 0, D / 2, D / 2};
    pg8::EpiSwiGLU E{a.ws + WS_HID, tk, (const float*)(a.ws + WS_GP)};
    pg8::gemm_phase<pg8::EpiSwiGLU, MoeOrder, true, true>(lds, g, S, E);
}
__device__ __forceinline__ void p6_moe_down(const Args& a, LAS unsigned char* lds) {
    LAS int* ps = (LAS int*)(lds + 131072); LAS int* cn = ps + 40;
    load_pstart(a, ps, cn);
    {
        MoeOrder S{ps, cn, (const int*)(a.ws + WS_LIST), (int)gridDim.x, (int)blockIdx.x, (ps[NE] / 256) * 4, nullptr};
        pg8::Gemm g{(const bf16*)(a.ws + WS_HID), (const bf16*)(a.ws + WS_WD), 0, 0, DE / 2, DE / 2};
        pg8::EpiStore8 E{a.ws + WS_YB, D, 3};
        pg8::gemm_phase<pg8::EpiStore8, MoeOrder, false, true>(lds, g, S, E);
    }
}

__device__ __forceinline__ void p7_proj(const Args& a, LAS unsigned char* lds) {
    {
        pg8::Gemm g{(const bf16*)(a.ws + WS_PB), (const bf16*)(a.ws + WS_WPLP), M, D, PLE, PLE}; pg8::Col4Order S; S.init(M, (int)gridDim.x, (int)blockIdx.x);
        pg8::EpiStore8 E{a.ws + WS_Y, D, 0xffff};
        pg8::gemm_phase<pg8::EpiStore8, pg8::Col4Order, false>(lds, g, S, E);
    }
}

__device__ __forceinline__ void p7_combine(const Args& a, LAS unsigned char* lds) {
    LAS int* ps = (LAS int*)lds; LAS int* cn = ps + 40;
    load_pstart(a, ps, cn);
    int tid_l = threadIdx.x; asm volatile("" : "+v"(tid_l)); const int tid = tid_l, lane = tid & 63, wave = tid >> 6;
    const int gw = blockIdx.x * NWAVES + wave, NGW = gridDim.x * NWAVES;
    float* xo = a.out; const float* g = a.in[18]; const unsigned char* YB = a.ws + WS_YB;
    const int4* toki = (const int4*)(a.ws + WS_TOKI); const float2* tokw = (const float2*)(a.ws + WS_TOKW);
    f32x4 gv[4];
#pragma unroll
    for (int j = 0; j < 4; ++j) gv[j] = *(const f32x4*)(g + 4 * lane + 256 * j);
    for (int m = gw * 2; m < M; m += NGW * 2) {
        f32x4 v[2][4]; unsigned ya[2][4], yb[2][4]; v2u ym[2][4]; float2 tw[2];
#pragma unroll
        for (int r = 0; r < 2; ++r) {
            const int4 ti = toki[m + r]; tw[r] = tokw[m + r]; tw[r].x *= F8_WINV; tw[r].y *= F8_WINV;
            const size_t r0 = (size_t)(ps[ti.x] + ti.z), r1 = (size_t)(ps[ti.y] + ti.w);
            const v2u* mr = (const v2u*)((const bf16*)xo + (size_t)(m + r) * 2048) + lane;
            const unsigned* y0 = (const unsigned*)(YB + r0 * D) + lane; const unsigned* y1 = (const unsigned*)(YB + r1 * D) + lane;
#pragma unroll
            for (int j = 0; j < 4; ++j) { v[r][j] = (f32x4){0.f, 0.f, 0.f, 0.f}; ya[r][j] = y0[64 * j]; yb[r][j] = y1[64 * j]; ym[r][j] = mr[64 * j]; }
        }
#pragma unroll
        for (int r = 0; r < 2; ++r) {
            float ss = 0.f; unsigned long long* x2b = (unsigned long long*)((bf16*)xo + (size_t)(m + r) * 2048) + lane;
#pragma unroll
            for (int j = 0; j < 4; ++j) {
                const v2u am = ym[r][j];
                const f32x2 a0l = __builtin_amdgcn_cvt_pk_f32_fp8((int)ya[r][j], false), a0h = __builtin_amdgcn_cvt_pk_f32_fp8((int)ya[r][j], true);
                const f32x2 a1l = __builtin_amdgcn_cvt_pk_f32_fp8((int)yb[r][j], false), a1h = __builtin_amdgcn_cvt_pk_f32_fp8((int)yb[r][j], true);
                v[r][j].x += __uint_as_float(am.x << 16) + tw[r].x * a0l.x + tw[r].y * a1l.x;
                v[r][j].y += __uint_as_float(am.x & 0xffff0000u) + tw[r].x * a0l.y + tw[r].y * a1l.y;
                v[r][j].z += __uint_as_float(am.y << 16) + tw[r].x * a0h.x + tw[r].y * a1h.x;
                v[r][j].w += __uint_as_float(am.y & 0xffff0000u) + tw[r].x * a0h.y + tw[r].y * a1h.y;
                x2b[64 * j] = (unsigned long long)pk2(v[r][j].x, v[r][j].y) | ((unsigned long long)pk2(v[r][j].z, v[r][j].w) << 32);
                ((unsigned*)(a.ws + WS_HN) + (size_t)(m + r) * 256 + lane)[64 * j] = pk8(v[r][j].x, v[r][j].y, v[r][j].z, v[r][j].w);
                ss += (v[r][j].x * v[r][j].x + v[r][j].y * v[r][j].y) + (v[r][j].z * v[r][j].z + v[r][j].w * v[r][j].w);
            }
            const float rstd = rsqrtf(wave_sum(ss) * (1.f / D) + EPS);
            if (lane == 0) ((float*)(a.ws + WS_GP))[M + m + r] = rstd;
        }
    }
}

__device__ __forceinline__ void p9_final(const Args& a) {
    int tid_l = threadIdx.x; asm volatile("" : "+v"(tid_l)); const int tid = tid_l, lane = tid & 63, wave = tid >> 6;
    const int gw = blockIdx.x * NWAVES + wave, NGW = gridDim.x * NWAVES;
    float* xo = a.out; const float* g = a.in[21];
    f32x4 gv[4];
#pragma unroll
    for (int j = 0; j < 4; ++j) gv[j] = *(const f32x4*)(g + 4 * lane + 256 * j);
    for (int m = gw * 2; m < M; m += NGW * 2) {
        f32x4 v[2][4]; float ss[2] = {0.f, 0.f};
        unsigned dl[2][4];
#pragma unroll
        for (int r = 0; r < 2; ++r) { const v2u* xr = (const v2u*)((const bf16*)xo + (size_t)(m + r) * 2048) + lane; const unsigned* dr = (const unsigned*)(a.ws + WS_Y + (size_t)(m + r) * D) + lane;
#pragma unroll
            for (int j = 0; j < 4; ++j) { const v2u xb = xr[64 * j]; v[r][j] = (f32x4){__uint_as_float(xb.x << 16), __uint_as_float(xb.x & 0xffff0000u), __uint_as_float(xb.y << 16), __uint_as_float(xb.y & 0xffff0000u)}; dl[r][j] = dr[64 * j]; } }
#pragma unroll
        for (int r = 0; r < 2; ++r)
#pragma unroll
            for (int j = 0; j < 4; ++j) { const f32x2 dlo = __builtin_amdgcn_cvt_pk_f32_fp8((int)dl[r][j], false), dhi = __builtin_amdgcn_cvt_pk_f32_fp8((int)dl[r][j], true); v[r][j].x += dlo.x; v[r][j].y += dlo.y; v[r][j].z += dhi.x; v[r][j].w += dhi.y;
                ss[r] += (v[r][j].x * v[r][j].x + v[r][j].y * v[r][j].y) + (v[r][j].z * v[r][j].z + v[r][j].w * v[r][j].w); }
#pragma unroll
        for (int r = 0; r < 2; ++r) { const float rstd = rsqrtf(wave_sum(ss[r]) * (1.f / D) + EPS); f32x4* xr = (f32x4*)(xo + (size_t)(m + r) * D) + lane;
#pragma unroll
            for (int j = 0; j < 4; ++j) xr[64 * j] = v[r][j] * rstd * gv[j]; }
    }
}


__device__ __forceinline__ void p1_gemm_in(const Args& args, LAS unsigned char* lds) {
    pg8::Gemm g{(const bf16*)(args.ws + WS_HN), (const bf16*)(args.ws + WS_WIN), M, ZC, D, D}; pg8::StaticOrder S; S.init(M, ZC, (int)gridDim.x, (int)blockIdx.x);
    pg8::EpiStore E{(bf16*)(args.ws + WS_Z), ZC, 0xffff};
    pg8::gemm_phase<pg8::EpiStore, pg8::StaticOrder, false>(lds, g, S, E);
}
__device__ __forceinline__ void p3_gemm_out(const Args& args, LAS unsigned char* lds) {
    pg8::Gemm g{(const bf16*)(args.ws + WS_Y), (const bf16*)(args.ws + WS_WOUT), M, D, D, D}; pg8::StaticOrder S; S.init(M, D, (int)gridDim.x, (int)blockIdx.x);
    pg8::EpiStore E{(bf16*)args.out + 1024, 2048, 0xffff};
    pg8::gemm_phase<pg8::EpiStore, pg8::StaticOrder, false>(lds, g, S, E);
}
__device__ __forceinline__ void p8_gemm_ple(const Args& args, LAS unsigned char* lds) {
    pg8::Gemm g{(const bf16*)(args.ws + WS_HN), (const bf16*)(args.ws + WS_WPLG), M, D, D / 2, D / 2};       pg8::Col4Order S; S.init(M, (int)gridDim.x, (int)blockIdx.x);
    pg8::EpiPle E{args.ws + WS_Y, (const float*)(args.ws + WS_GP) + M};
    pg8::gemm_phase<pg8::EpiPle, pg8::Col4Order, false, true>(lds, g, S, E);
}


__device__ __forceinline__ const float* as_global(const float* p) { return (const float*)(const GAS float*)p; }
__device__ __forceinline__ Args ld_args() {
    const __attribute__((address_space(4))) Args* ap = (const __attribute__((address_space(4))) Args*)__builtin_amdgcn_kernarg_segment_ptr();
    asm volatile("" : "+s"(ap));
    Args a;
#pragma unroll
    for (int i = 0; i < 22; ++i) a.in[i] = as_global(ap->in[i]);
    a.out = (float*)(GAS float*)ap->out; a.ws = (unsigned char*)(GAS unsigned char*)ap->ws; a.ph_lo = ap->ph_lo; a.ph_hi = ap->ph_hi;
    return a;
}

__global__ void __launch_bounds__(NTHR, 2) fwd(Args kargs) {
    extern __shared__ __attribute__((aligned(16))) unsigned char lds_raw[];
    LAS unsigned char* lds = (LAS unsigned char*)lds_raw;
    const int lo = (N_LAUNCHES == 1) ? 0 : kargs.ph_lo, hi = (N_LAUNCHES == 1) ? PER_PHASE : kargs.ph_hi;
    volatile LAS unsigned* xbw = (volatile LAS unsigned*)(lds + LDS_XB);
    if (threadIdx.x < 4) xbw[threadIdx.x] = 0u;
    __syncthreads();
    XcdBarrier bar; bar.bar = (unsigned*)(kargs.ws + WS_CTL) + CW_BAR; bar.x = 0; bar.st = xbw;
    if (N_LAUNCHES != PER_PHASE) bar = xcd_barrier_post((unsigned*)(kargs.ws + WS_CTL) + CW_BAR, xbw);
#define IN(k) (lo <= (k) && (k) < hi)
#define PH_ARGS() const Args args = ld_args()
#define SEAM(k) do { if (IN(k) && IN((k) + 1)) xcd_barrier(bar); } while (0)
    if (IN(0)) { PH_ARGS(); p0_prologue(args, lds); if (PROBE_DUP == 0) { xcd_barrier(bar); p0_prologue(args, lds); } }
    SEAM(0);
    if (IN(1)) { PH_ARGS(); p1_gemm_in(args, lds); if (PROBE_DUP == 1) { xcd_barrier(bar); p1_gemm_in(args, lds); } }
    SEAM(1);
    if (IN(2)) { PH_ARGS(); p2_mixers_fast(args, lds); if (PROBE_DUP == 2) { xcd_barrier(bar); p2_mixers_fast(args, lds); } }
    SEAM(2);
    if (IN(3)) { PH_ARGS(); p3_gemm_out(args, lds); if (PROBE_DUP == 3) { xcd_barrier(bar); p3_gemm_out(args, lds); } }
    SEAM(3);
    if (IN(4)) { PH_ARGS(); p4_router(args, lds); }
    SEAM(4);
    if (IN(5)) { PH_ARGS(); p5_moe_up(args, lds); if (PROBE_DUP == 5) { xcd_barrier(bar); p5_moe_up(args, lds); } }
    SEAM(5);
    if (IN(6)) { PH_ARGS(); p6_moe_down(args, lds); if (PROBE_DUP == 6) { xcd_barrier(bar); p6_moe_down(args, lds); } }
    SEAM(6);
    if (IN(7)) { PH_ARGS(); p7_combine(args, lds); __syncthreads(); p7_proj(args, lds); }
    SEAM(7);
    if (IN(8)) { PH_ARGS(); p8_gemm_ple(args, lds); }
    SEAM(8);
    if (IN(9)) { PH_ARGS(); p9_final(args); }
#undef IN
#undef SEAM
}

extern "C" void kernel_launch(void* const* d_in, const int* in_sizes, int n_in, void* d_out, int out_size, void* d_ws, size_t ws_size, hipStream_t stream) {
    static int grid = 0;
    if (grid == 0) {
        if (n_in != 22 || in_sizes[0] != M * D || out_size != M * D || ws_size < WS_END) {
            fprintf(stderr, "kernel_launch: unexpected shapes (n_in %d, in0 %d, out %d, ws %zu); nothing launched\n", n_in, n_in > 0 ? in_sizes[0] : -1, out_size, ws_size); grid = -1; return; }
        int dev = 0, cus = 0;
        if (hipGetDevice(&dev) != hipSuccess || hipDeviceGetAttribute(&cus, hipDeviceAttributeMultiprocessorCount, dev) != hipSuccess) { grid = -1; return; }
        if (hipFuncSetAttribute((const void*)fwd, hipFuncAttributeMaxDynamicSharedMemorySize, LDS_BYTES) != hipSuccess) { fprintf(stderr, "kernel_launch: hipFuncSetAttribute failed\n"); grid = -1; return; }
        int per_cu = 0;
        if (hipOccupancyMaxActiveBlocksPerMultiprocessor(&per_cu, (const void*)fwd, NTHR, LDS_BYTES) != hipSuccess || per_cu < 1) fprintf(stderr, "kernel_launch: occupancy query says %d\n", per_cu);
        (void)hipGetLastError();
        grid = cus;
    }
    if (grid < 0) return;
    (void)hipMemsetAsync((char*)d_ws + WS_CTL, 0, CTL_ZERO_BYTES, stream);
    Args a{};
    for (int i = 0; i < 22; ++i) a.in[i] = (const float*)d_in[i];
    a.out = (float*)d_out; a.ws = (unsigned char*)d_ws;
    if (N_LAUNCHES == PER_PHASE) {
        for (int li = 0; li < PER_PHASE; ++li) { a.ph_lo = li; a.ph_hi = li + 1; hipLaunchKernelGGL(fwd, dim3(grid), dim3(NTHR), LDS_BYTES, stream, a); }
    } else {
        a.ph_lo = 0; a.ph_hi = PER_PHASE; hipLaunchKernelGGL(fwd, dim3(grid), dim3(NTHR), LDS_BYTES, stream, a);
    }
}
```
